# Optimizing an MI355X kernel written in HIP

```python
import jax
import jax.numpy as jnp
from jax import lax
import numpy as np

D_MODEL = 1024
BATCH = 16
SEQ = 256
DEPTH = 4
DEC_BATCH = 8
DEC_SEQ = 1024
PAST_LEN = 256

GRID_W = 64
N_MIXERS = 3
N_ATTN_LAYERS = (DEPTH + 2) // 3
N_CONV_LAYERS = (DEPTH + 1) // 3
N_HGRN_LAYERS = DEPTH // 3
N_MOD = 9
N_NORMS = 6
D_FF = 2816
FFN_RES = 0.5
ATTN_HEADS = 16
ATTN_KV_HEADS = 4
ATTN_GROUPS = ATTN_HEADS // ATTN_KV_HEADS
HEAD_DIM = 64
ATTN_DIM = ATTN_HEADS * HEAD_DIM
WINDOW = 128
BLOCK = 128
ATTN_SCALE = HEAD_DIM ** -0.5
ROPE_BASE = 10000.0
ROPE_PAIRS_PER_AXIS = HEAD_DIM // 4
CONV_WIDTH = 3
HGRN_HEADS = 8
HGRN_DK = 128
HGRN_DV = D_MODEL // HGRN_HEADS
HGRN_FD = HGRN_HEADS * HGRN_DK
CHUNK = 16
EPS = 1e-6

kernel_name = 'hybrid_diffusion_prefix_trunk_step'


def rmsnorm(x, g):
    xf = x.astype(jnp.float32)
    y = xf * lax.rsqrt(jnp.mean(xf * xf, axis=-1, keepdims=True) + EPS)
    return y.astype(x.dtype) * g


def modulate(x, shift, scale):
    return x * (1 + scale) + shift


def adaln(cond, w, b):
    m = jax.nn.silu(cond) @ w + b
    return [t[:, None, :] for t in jnp.split(m, N_MOD, axis=-1)]


def ffn_sublayer(x, shift, scale, gate, g_pre, g_post, w_in, w_out):
    h = modulate(rmsnorm(x, g_pre), shift, scale)
    a, b = jnp.split(h @ w_in, 2, axis=-1)
    h = (jax.nn.silu(a) * b) @ w_out
    return x + FFN_RES * gate * rmsnorm(h, g_post)


def axial_rope(L):
    rows = L // GRID_W
    row = jnp.repeat(jnp.arange(rows), GRID_W).astype(jnp.float32)
    col = jnp.tile(jnp.arange(GRID_W), rows).astype(jnp.float32)
    inv = ROPE_BASE ** (-jnp.arange(ROPE_PAIRS_PER_AXIS, dtype=jnp.float32) / ROPE_PAIRS_PER_AXIS)
    ang = jnp.concatenate([row[:, None] * inv, col[:, None] * inv], axis=-1)
    return jnp.cos(ang), jnp.sin(ang)


def apply_rope(x, cos, sin):
    x1, x2 = jnp.split(x, 2, axis=-1)
    c = cos[None, :, None, :]
    s = sin[None, :, None, :]
    return jnp.concatenate([x1 * c - x2 * s, x1 * s + x2 * c], axis=-1).astype(x.dtype)


def attn_project(h, w_qkv):
    B, L, _ = h.shape
    q, k, v = jnp.split(h @ w_qkv, [ATTN_DIM, ATTN_DIM + ATTN_KV_HEADS * HEAD_DIM], axis=-1)
    return (q.reshape(B, L, ATTN_HEADS, HEAD_DIM),
            k.reshape(B, L, ATTN_KV_HEADS, HEAD_DIM),
            v.reshape(B, L, ATTN_KV_HEADS, HEAD_DIM))


def sink_logits(sink, shape):
    s = sink.astype(jnp.float32).reshape(ATTN_KV_HEADS, ATTN_GROUPS)
    s = s.reshape((1,) * (len(shape) - 4) + (ATTN_KV_HEADS, ATTN_GROUPS, 1, 1))
    return jnp.broadcast_to(s, shape[:-1] + (1,))


def attn_context(h, w_qkv, w_o, sink):
    B, L, _ = h.shape
    q, k, v = attn_project(h, w_qkv)
    nqb = L // BLOCK
    qb = jnp.moveaxis(q.reshape(B, nqb, BLOCK, ATTN_KV_HEADS, ATTN_GROUPS, HEAD_DIM), 1, 0)

    def block(qi):
        s = jnp.einsum('bqkgd,bskd->bkgqs', qi, k).astype(jnp.float32) * ATTN_SCALE
        p = jax.nn.softmax(jnp.concatenate([s, sink_logits(sink, s.shape)], axis=-1), axis=-1)
        return jnp.einsum('bkgqs,bskd->bqkgd', p[..., :-1].astype(v.dtype), v)

    o = jnp.moveaxis(lax.map(block, qb), 0, 1).reshape(B, L, ATTN_DIM)
    return o @ w_o, k, v


def attn_latent(h, w_qkv, w_o, sink, k_ctx, v_ctx):
    B, L, _ = h.shape
    q, k, v = attn_project(h, w_qkv)
    cos, sin = axial_rope(L)
    q = apply_rope(q, cos, sin)
    k = apply_rope(k, cos, sin)
    nb = L // BLOCK
    qb = q.reshape(B, nb, BLOCK, ATTN_KV_HEADS, ATTN_GROUPS, HEAD_DIM)

    def band(t):
        tp = jnp.pad(t, ((0, 0), (BLOCK, BLOCK), (0, 0), (0, 0))).reshape(B, nb + 2, BLOCK, ATTN_KV_HEADS, HEAD_DIM)
        return jnp.concatenate([tp[:, :-2], tp[:, 1:-1], tp[:, 2:]], axis=2)

    kb, vb = band(k), band(v)
    n_band = 3 * BLOCK
    qi = jnp.arange(BLOCK)[:, None]
    u = jnp.arange(n_band)[None, :]
    in_window = jnp.abs(qi + BLOCK - u) <= WINDOW
    kpos = (jnp.arange(nb)[:, None] - 1) * BLOCK + jnp.arange(n_band)[None, :]
    in_range = (kpos >= 0) & (kpos < L)
    mask = in_window[None] & in_range[:, None, :]
    s_lat = jnp.einsum('bnqkgd,bnskd->bnkgqs', qb, kb).astype(jnp.float32) * ATTN_SCALE
    s_lat = jnp.where(mask[None, :, None, None], s_lat, -jnp.inf)
    s_ctx = jnp.einsum('bnqkgd,bskd->bnkgqs', qb, k_ctx).astype(jnp.float32) * ATTN_SCALE
    logits = jnp.concatenate([s_lat, s_ctx, sink_logits(sink, s_lat.shape)], axis=-1)
    p = jax.nn.softmax(logits, axis=-1).astype(v.dtype)
    o = (jnp.einsum('bnkgqs,bnskd->bnqkgd', p[..., :n_band], vb)
         + jnp.einsum('bnkgqs,bskd->bnqkgd', p[..., n_band:-1], v_ctx))
    return o.reshape(B, L, ATTN_DIM) @ w_o


def short_conv(h, w_in, cw, cb, w_out):
    L = h.shape[1]
    bg, cg, u = jnp.split(h @ w_in, 3, axis=-1)
    z = cg * u
    pad = CONV_WIDTH // 2
    zp = jnp.pad(z, ((0, 0), (pad, pad), (0, 0)))
    conv = cb + sum(zp[:, j:j + L] * cw[j] for j in range(CONV_WIDTH))
    return (bg * conv) @ w_out


def chunk_gla(q, k, v, logf, s0):
    B, L, H, _ = q.shape
    DV = v.shape[-1]
    n = L // CHUNK
    q, k, v, logf = (t.astype(jnp.float32).reshape(B, n, CHUNK, H, t.shape[-1]) for t in (q, k, v, logf))
    b = jnp.cumsum(logf, axis=2)
    tri = jnp.tril(jnp.ones((CHUNK, CHUNK), bool))
    diff = b[:, :, :, None] - b[:, :, None, :]
    decay = jnp.exp(jnp.where(tri[None, None, :, :, None, None], diff, -jnp.inf))
    scores = jnp.einsum('bnthd,bnshd,bntshd->bnhts', q, k, decay)
    o_intra = jnp.einsum('bnhts,bnshv->bnthv', scores, v)
    b_last = b[:, :, -1]
    kv = jnp.einsum('bnshd,bnshv->bnhdv', k * jnp.exp(b_last[:, :, None] - b), v)

    def step(S, xs):
        dec, kv_n = xs
        return dec[..., None] * S + kv_n, S

    S_fin, S_prev = lax.scan(step, s0.astype(jnp.float32),
                             (jnp.moveaxis(jnp.exp(b_last), 1, 0), jnp.moveaxis(kv, 1, 0)))
    S_prev = jnp.moveaxis(S_prev, 0, 1)
    o_inter = jnp.einsum('bnthd,bnhdv->bnthv', q * jnp.exp(b), S_prev)
    return (o_intra + o_inter).reshape(B, L, H, DV), S_fin


def hgrn_lower_bound(lb_param, li):
    p = jax.nn.softmax(lb_param.astype(jnp.float32), axis=0)
    return jnp.cumsum(p, axis=0)[li] - p[0]


def hgrn_mixer(h, w_in, lb_f, lb_b, norm_g, w_out, s0_f, s0_b):
    B, L, _ = h.shape
    zq, zi, zf, zb, zg = jnp.split(
        h @ w_in, [HGRN_FD, HGRN_FD + D_MODEL, 2 * HGRN_FD + D_MODEL, 3 * HGRN_FD + D_MODEL], axis=-1)
    heads = lambda t: t.reshape(B, L, HGRN_HEADS, -1)
    q = heads(jax.nn.silu(zq)) * HGRN_DK ** -0.5
    v = heads(zi)

    def gates(z, lb):
        lb = lb.reshape(HGRN_HEADS, HGRN_DK)
        f = lb + (1 - lb) * jax.nn.sigmoid(heads(z).astype(jnp.float32))
        return 1 - f, jnp.log(f)

    k_f, lf_f = gates(zf, lb_f)
    k_b, lf_b = gates(zb, lb_b)
    rev = lambda t: jnp.flip(t, axis=1)
    o_f, S_f = chunk_gla(q, k_f, v, lf_f, s0_f)
    o_b, S_b = chunk_gla(rev(q), rev(k_b), rev(v), rev(lf_b), s0_b)
    o = o_f + rev(o_b)
    o = rmsnorm(o, norm_g) * jax.nn.silu(heads(zg))
    return o.reshape(B, L, D_MODEL).astype(h.dtype) @ w_out, S_f.astype(h.dtype), S_b.astype(h.dtype)


def setup_inputs(seed: int = 0) -> dict:
    key = jax.random.key(seed)
    ks = jax.random.split(key, 24)
    nrm = lambda k, shape, s: jax.random.normal(k, shape, jnp.float32) * s
    D = D_MODEL
    qkv_dim = ATTN_DIM + 2 * ATTN_KV_HEADS * HEAD_DIM
    return {
        'x_prompt': nrm(ks[0], (BATCH, SEQ, D), 1.0),
        'x_sample': nrm(ks[1], (DEC_BATCH, DEC_SEQ, D), 1.0),
        'cache_k': nrm(ks[2], (DEC_BATCH, N_ATTN_LAYERS, PAST_LEN, ATTN_KV_HEADS, HEAD_DIM), 1.0),
        'cache_v': nrm(ks[3], (DEC_BATCH, N_ATTN_LAYERS, PAST_LEN, ATTN_KV_HEADS, HEAD_DIM), 1.0),
        'state_hgrn': nrm(ks[4], (DEC_BATCH, N_HGRN_LAYERS, 2, HGRN_HEADS, HGRN_DK, HGRN_DV), 0.5),
        'c': nrm(ks[5], (DEC_BATCH, D), 1.0),
        'c_ctx': nrm(ks[6], (D,), 1.0),
        'w_ada': nrm(ks[7], (DEPTH, D, N_MOD * D), 0.5 * D ** -0.5),
        'b_ada': nrm(ks[8], (DEPTH, N_MOD * D), 0.01),
        'norm_g': 1.0 + nrm(ks[9], (DEPTH, N_NORMS, D), 0.05),
        'w_ffn_in': nrm(ks[10], (DEPTH, 2, D, 2 * D_FF), D ** -0.5),
        'w_ffn_out': nrm(ks[11], (DEPTH, 2, D_FF, D), D_FF ** -0.5),
        'w_attn_qkv': nrm(ks[12], (N_ATTN_LAYERS, D, qkv_dim), D ** -0.5),
        'w_attn_o': nrm(ks[13], (N_ATTN_LAYERS, ATTN_DIM, D), ATTN_DIM ** -0.5),
        'attn_sink': nrm(ks[14], (N_ATTN_LAYERS, ATTN_HEADS), 1.0),
        'w_conv_in': nrm(ks[15], (N_CONV_LAYERS, D, 3 * D), D ** -0.5),
        'conv_w': nrm(ks[16], (N_CONV_LAYERS, CONV_WIDTH, D), CONV_WIDTH ** -0.5),
        'conv_b': nrm(ks[17], (N_CONV_LAYERS, D), 0.01),
        'w_conv_out': nrm(ks[18], (N_CONV_LAYERS, D, D), D ** -0.5),
        'w_hgrn_in': nrm(ks[19], (N_HGRN_LAYERS, D, 3 * HGRN_FD + 2 * D), D ** -0.5),
        'hgrn_lb': nrm(ks[20], (2, DEPTH, HGRN_FD), 1.0),
        'hgrn_norm_g': 1.0 + nrm(ks[21], (N_HGRN_LAYERS, HGRN_DV), 0.05),
        'w_hgrn_out': nrm(ks[22], (N_HGRN_LAYERS, D, D), D ** -0.5),
    }


def reference(x_prompt, x_sample, cache_k, cache_v, state_hgrn, c, c_ctx, w_ada, b_ada, norm_g,
              w_ffn_in, w_ffn_out, w_attn_qkv, w_attn_o, attn_sink, w_conv_in, conv_w, conv_b,
              w_conv_out, w_hgrn_in, hgrn_lb, hgrn_norm_g, w_hgrn_out):
    yp, ys = x_prompt, x_sample
    Bp = x_prompt.shape[0]
    Bs = x_sample.shape[0]
    new_k, new_v, new_s = [], [], []
    for li in range(DEPTH):
        kind, j = li % N_MIXERS, li // N_MIXERS
        mp = adaln(c_ctx[None, :], w_ada[li], b_ada[li])
        ms = adaln(c, w_ada[li], b_ada[li])
        g = norm_g[li]
        yp = ffn_sublayer(yp, mp[0], mp[1], mp[2], g[0], g[1], w_ffn_in[li, 0], w_ffn_out[li, 0])
        ys = ffn_sublayer(ys, ms[0], ms[1], ms[2], g[0], g[1], w_ffn_in[li, 0], w_ffn_out[li, 0])
        hp = modulate(rmsnorm(yp, g[2]), mp[3], mp[4])
        hs = modulate(rmsnorm(ys, g[2]), ms[3], ms[4])
        if kind == 0:
            op, kc, vc = attn_context(hp, w_attn_qkv[j], w_attn_o[j], attn_sink[j])
            os_ = attn_latent(hs, w_attn_qkv[j], w_attn_o[j], attn_sink[j], cache_k[:, j], cache_v[:, j])
            new_k.append(kc)
            new_v.append(vc)
        elif kind == 1:
            op = short_conv(hp, w_conv_in[j], conv_w[j], conv_b[j], w_conv_out[j])
            os_ = short_conv(hs, w_conv_in[j], conv_w[j], conv_b[j], w_conv_out[j])
        else:
            lb_f = hgrn_lower_bound(hgrn_lb[0], li)
            lb_b = hgrn_lower_bound(hgrn_lb[1], li)
            z0 = jnp.zeros((Bp, HGRN_HEADS, HGRN_DK, HGRN_DV), jnp.float32)
            op, sf, sb = hgrn_mixer(hp, w_hgrn_in[j], lb_f, lb_b, hgrn_norm_g[j], w_hgrn_out[j], z0, z0)
            os_, _, _ = hgrn_mixer(hs, w_hgrn_in[j], lb_f, lb_b, hgrn_norm_g[j], w_hgrn_out[j],
                                   state_hgrn[:, j, 0], state_hgrn[:, j, 1])
            new_s.append(jnp.stack([sf, sb], axis=1))
        yp = yp + mp[5] * rmsnorm(op, g[3])
        ys = ys + ms[5] * rmsnorm(os_, g[3])
        yp = ffn_sublayer(yp, mp[6], mp[7], mp[8], g[4], g[5], w_ffn_in[li, 1], w_ffn_out[li, 1])
        ys = ffn_sublayer(ys, ms[6], ms[7], ms[8], g[4], g[5], w_ffn_in[li, 1], w_ffn_out[li, 1])
    new_cache_k = jnp.stack(new_k, axis=1)
    new_cache_v = jnp.stack(new_v, axis=1)
    new_state_hgrn = jnp.stack(new_s, axis=1)
    return (yp, ys, new_cache_k, new_cache_v, new_state_hgrn)
```

```cpp
#include <hip/hip_runtime.h>
#include <hip/hip_cooperative_groups.h>
#include <cstdio>
#include <cstdint>
namespace cg = cooperative_groups;
__device__ __forceinline__ int opaque_tid() { int t = threadIdx.x; asm volatile("" : "+v"(t)); return t; }
namespace pg8 {
#define PG8_LAS __attribute__((address_space(3)))
typedef unsigned short bf16_t;
typedef short bf16x8 __attribute__((ext_vector_type(8)));
typedef float f32x4 __attribute__((ext_vector_type(4)));
typedef unsigned u32x4 __attribute__((ext_vector_type(4)));
constexpr int BM = 256, BK = 64, HALF = 128, HTB = HALF * BK * 2  , STAGE_BYTES = 8 * HTB, NXCD = 8, WGM = 8;

__host__ __device__ __forceinline__ int lds_byte(int r, int c) { const int st = (r >> 4) * 2 + (c >> 5), rr = r & 15, cc = c & 31, ob = rr * 64 + cc * 2; return st * 1024 + (ob ^ (((ob >> 9) & 1) << 5)); }
__host__ __device__ __forceinline__ void stage_rc(int b, int& R, int& C) { const int st = b / 1024, sb = b % 1024, swz = sb ^ (((sb >> 9) & 1) << 5); R = (st >> 1) * 16 + swz / 64; C = (st & 1) * 32 + (swz % 64) / 2; }
__host__ __device__ __forceinline__ int perm32(int rho) { const int n = rho >> 4, i = rho & 15; return 8 * (i >> 2) + 4 * n + (i & 3); }

struct Unit { int pm, pn; };
struct Gemm { const bf16_t* A; const bf16_t* Bt; int M, N, K; };

struct StaticOrder {
    int nM, nN, nwg, G, c;
    __host__ __device__ void init(int M, int N, int G_, int c_) { nM = M / BM; nN = N / BM; nwg = nM * nN; G = G_; c = c_; }
    __host__ __device__ bool next(int i, Unit& u) const {
        const long L = (long)i * G + c; if (L >= nwg) return false;
        int wgid = (int)L; { const int q = nwg / NXCD, r = nwg % NXCD, xcd = wgid % NXCD, off = wgid / NXCD; wgid = (xcd < r ? xcd * (q + 1) : r * (q + 1) + (xcd - r) * q) + off; }
        const int nig = WGM * nN, gid = wgid / nig, fm = gid * WGM, gsz = (nM - fm) < WGM ? (nM - fm) : WGM;
        u.pm = fm + ((wgid % nig) % gsz); u.pn = (wgid % nig) / gsz; return true;
    }
    __device__ __forceinline__ void a_ready(const Unit&) const {}
    __device__ __forceinline__ void done(const Unit&) const {}
};

__device__ __forceinline__ unsigned cvt_pk_bf16(float lo, float hi) { unsigned r; asm volatile("v_cvt_pk_bf16_f32 %0, %1, %2" : "=v"(r) : "v"(lo), "v"(hi)); return r; }
typedef float f32x2 __attribute__((ext_vector_type(2)));
template <class Epi, class Sched, bool ALIGN_EPI = false, bool SP2 = false>
__device__ __forceinline__ void gemm_phase(PG8_LAS unsigned char* lds, const Gemm g, const Sched& S, const Epi& E) {
    const int tid = opaque_tid(), wid = __builtin_amdgcn_readfirstlane(tid >> 6), lane = tid & 63, wr = wid >> 2, wc = wid & 3, fr = lane & 15, fq = lane >> 4;
    const int K = g.K, nt = K / BK;
    unsigned voffA[2], voffB[2];
#pragma unroll
    for (int i = 0; i < 2; ++i) { int R, C; stage_rc(tid * 16 + i * 8192, R, C); const int Rb = Epi::PERM ? ((R & ~31) + perm32(R & 31)) : R;
        voffA[i] = (unsigned)(R * K + C) * 2u; voffB[i] = (unsigned)(Rb * K + C) * 2u; }
    const size_t kstep = (size_t)(BK * 2);
    const size_t hstep = (size_t)HALF * K * 2;
    const size_t tstep = 2 * hstep;
    const unsigned ldsw = (unsigned)wid * 1024u;
    const int aoff = lds_byte(wr * 64 + fr, fq * 8), boff = lds_byte(wc * 32 + fr, fq * 8);
#define PG8_SA(b, h) (((b) * 2 + (h)) * HTB)
#define PG8_SB(b, h) ((4 + (b) * 2 + (h)) * HTB)
#define PG8_STAGE(bufoff, gbase, voff) do { _Pragma("unroll") for (int _i = 0; _i < 2; ++_i) \
        __builtin_amdgcn_global_load_lds((const unsigned*)((const char*)(gbase) + (voff)[_i]), (PG8_LAS unsigned*)(lds + (bufoff) + ldsw + _i * 8192), 16, 0, 0); } while (0)
#define PG8_LDA(dst, b, h) do { _Pragma("unroll") for (int m = 0; m < 4; ++m) _Pragma("unroll") for (int k = 0; k < 2; ++k) dst[m][k] = *(const PG8_LAS bf16x8*)(lds + PG8_SA(b, h) + aoff + m * 2048 + k * 1024); } while (0)
#define PG8_LDB(dst, b, h) do { _Pragma("unroll") for (int n = 0; n < 2; ++n) _Pragma("unroll") for (int k = 0; k < 2; ++k) dst[n][k] = *(const PG8_LAS bf16x8*)(lds + PG8_SB(b, h) + boff + n * 2048 + k * 1024); } while (0)
#define PG8_MMA(ai, bj, At, Bt) do { __builtin_amdgcn_s_setprio(1); _Pragma("unroll") for (int m = 0; m < 4; ++m) _Pragma("unroll") for (int n = 0; n < 2; ++n) _Pragma("unroll") for (int k = 0; k < 2; ++k) \
        acc[ai][bj][m][n] = __builtin_amdgcn_mfma_f32_16x16x32_bf16(Bt[n][k], At[m][k], acc[ai][bj][m][n], 0, 0, 0); __builtin_amdgcn_s_setprio(0); } while (0)
#define PG8_WAIT_V(n) asm volatile("s_waitcnt vmcnt(" #n ")" ::: "memory")
#define PG8_WAIT_L(n) asm volatile("s_waitcnt lgkmcnt(" #n ")" ::: "memory")
#define PG8_BAR __builtin_amdgcn_s_barrier()
#define PG8_SCHED __builtin_amdgcn_sched_barrier(0)
    Unit cur, nxt; int ui = 0;
    if (!S.next(0, cur)) return;
    f32x4 acc[2][2][4][2];
#pragma unroll
    for (int a = 0; a < 2; ++a)
#pragma unroll
        for (int b = 0; b < 2; ++b)
#pragma unroll
            for (int m = 0; m < 4; ++m)
#pragma unroll
                for (int n = 0; n < 2; ++n) acc[a][b][m][n] = (f32x4){0.f, 0.f, 0.f, 0.f};
    bf16x8 At[4][2], B0[2][2], B1[2][2];
    const char* cA = (const char*)g.A + (size_t)cur.pm * tstep; const char* cB = (const char*)g.Bt + (size_t)cur.pn * tstep;
    S.a_ready(cur);
    if constexpr (SP2) {
        PG8_STAGE(PG8_SB(0, 0), cB, voffB); PG8_STAGE(PG8_SB(0, 1), cB + hstep, voffB); PG8_STAGE(PG8_SA(0, 0), cA, voffA); PG8_STAGE(PG8_SA(0, 1), cA + hstep, voffA);
        if (wr == 1) PG8_BAR;
        PG8_WAIT_V(2); PG8_BAR;
        PG8_STAGE(PG8_SB(1, 0), cB + kstep, voffB); PG8_STAGE(PG8_SA(1, 0), cA + kstep, voffA); PG8_STAGE(PG8_SB(1, 1), cB + hstep + kstep, voffB);
        PG8_WAIT_V(6); PG8_BAR;
    } else {
        PG8_STAGE(PG8_SB(0, 0), cB, voffB); PG8_STAGE(PG8_SA(0, 0), cA, voffA); PG8_STAGE(PG8_SB(0, 1), cB + hstep, voffB); PG8_STAGE(PG8_SA(0, 1), cA + hstep, voffA);
        if (wr == 1) PG8_BAR;
        PG8_WAIT_V(4); PG8_BAR;
        PG8_STAGE(PG8_SB(1, 0), cB + kstep, voffB); PG8_STAGE(PG8_SA(1, 0), cA + kstep, voffA); PG8_STAGE(PG8_SB(1, 1), cB + hstep + kstep, voffB);
        PG8_WAIT_V(6); PG8_BAR;
    }
    for (;;) {
        const bool has_next = S.next(ui + 1, nxt);
        const char* nA = has_next ? (const char*)g.A + (size_t)nxt.pm * tstep : cA; const char* nB = has_next ? (const char*)g.Bt + (size_t)nxt.pn * tstep : cB;
        for (int t = 0; t < nt; t += 2) {
            const bool last = (t == nt - 2);
            const char* a1 = cA + (size_t)(t + 1) * kstep;
            const char* a2 = last ? nA : cA + (size_t)(t + 2) * kstep; const char* b2 = last ? nB : cB + (size_t)(t + 2) * kstep;
            const char* a3 = a2 + kstep; const char* b3 = b2 + kstep;
            if (last && has_next) S.a_ready(nxt);
            if constexpr (SP2) {
            PG8_LDB(B0, 0, 0); PG8_LDB(B1, 0, 1); PG8_SCHED; PG8_LDA(At, 0, 0); PG8_STAGE(PG8_SA(1, 1), a1 + hstep, voffA);
            PG8_WAIT_V(8); PG8_WAIT_L(0); PG8_BAR; PG8_MMA(0, 0, At, B0); PG8_MMA(0, 1, At, B1); PG8_BAR; PG8_SCHED;
            PG8_LDA(At, 0, 1); PG8_STAGE(PG8_SB(0, 0), b2, voffB); PG8_STAGE(PG8_SB(0, 1), b2 + hstep, voffB); PG8_STAGE(PG8_SA(0, 0), a2, voffA);
            PG8_WAIT_V(8); PG8_WAIT_L(0); PG8_BAR; PG8_MMA(1, 0, At, B0); PG8_MMA(1, 1, At, B1); PG8_BAR; PG8_SCHED;
            PG8_LDB(B0, 1, 0); PG8_LDB(B1, 1, 1); PG8_SCHED; PG8_LDA(At, 1, 0); PG8_STAGE(PG8_SA(0, 1), a2 + hstep, voffA);
            PG8_WAIT_V(8); PG8_WAIT_L(0); PG8_BAR; PG8_MMA(0, 0, At, B0); PG8_MMA(0, 1, At, B1); PG8_BAR; PG8_SCHED;
            PG8_LDA(At, 1, 1); PG8_STAGE(PG8_SB(1, 0), b3, voffB); PG8_STAGE(PG8_SB(1, 1), b3 + hstep, voffB); PG8_STAGE(PG8_SA(1, 0), a3, voffA);
            PG8_WAIT_V(8); PG8_WAIT_L(0); PG8_BAR; PG8_MMA(1, 0, At, B0); PG8_MMA(1, 1, At, B1); PG8_BAR; PG8_SCHED;
            } else {
            PG8_LDB(B0, 0, 0); PG8_SCHED; PG8_LDA(At, 0, 0); PG8_STAGE(PG8_SA(1, 1), a1 + hstep, voffA);
            PG8_WAIT_L(8); PG8_BAR; PG8_WAIT_L(0); PG8_MMA(0, 0, At, B0); PG8_BAR; PG8_SCHED;
            PG8_LDB(B1, 0, 1); PG8_STAGE(PG8_SB(0, 0), b2, voffB);
            PG8_BAR; PG8_WAIT_L(0); PG8_MMA(0, 1, At, B1); PG8_BAR;
            PG8_LDA(At, 0, 1); PG8_STAGE(PG8_SA(0, 0), a2, voffA);
            PG8_BAR; PG8_WAIT_L(0); PG8_MMA(1, 0, At, B0); PG8_BAR; PG8_SCHED;
            PG8_STAGE(PG8_SB(0, 1), b2 + hstep, voffB);
            PG8_WAIT_V(6); PG8_BAR; PG8_MMA(1, 1, At, B1); PG8_BAR;
            PG8_LDB(B0, 1, 0); PG8_SCHED; PG8_LDA(At, 1, 0); PG8_STAGE(PG8_SA(0, 1), a2 + hstep, voffA);
            PG8_WAIT_L(8); PG8_BAR; PG8_WAIT_L(0); PG8_MMA(0, 0, At, B0); PG8_BAR; PG8_SCHED;
            PG8_LDB(B1, 1, 1); PG8_STAGE(PG8_SB(1, 0), b3, voffB);
            PG8_BAR; PG8_WAIT_L(0); PG8_MMA(0, 1, At, B1); PG8_BAR;
            PG8_LDA(At, 1, 1); PG8_STAGE(PG8_SA(1, 0), a3, voffA);
            PG8_BAR; PG8_WAIT_L(0); PG8_MMA(1, 0, At, B0); PG8_BAR; PG8_SCHED;
            PG8_STAGE(PG8_SB(1, 1), b3 + hstep, voffB);
            PG8_WAIT_V(6); PG8_BAR; PG8_MMA(1, 1, At, B1); PG8_BAR;
            }
        }
        if constexpr (ALIGN_EPI) { if (wr == 0) PG8_BAR; }
        if constexpr (!Epi::AFTER_DRAIN) { E(acc, cur, wr, wc, fr, fq); S.done(cur); }
        if (!has_next) break;
#pragma unroll
        for (int a = 0; a < 2; ++a)
#pragma unroll
            for (int b = 0; b < 2; ++b)
#pragma unroll
                for (int m = 0; m < 4; ++m)
#pragma unroll
                    for (int n = 0; n < 2; ++n) acc[a][b][m][n] = (f32x4){0.f, 0.f, 0.f, 0.f};
        cur = nxt; cA = nA; cB = nB; ++ui;
        if constexpr (ALIGN_EPI) { if (wr == 1) PG8_BAR; }
    }
    PG8_WAIT_V(0);
    if constexpr (!ALIGN_EPI) { if (wr == 0) PG8_BAR; }
    PG8_BAR;
    if constexpr (Epi::AFTER_DRAIN) { E.fused(acc, cur, wr, wc, fr, fq, lds, wid, lane); S.done(cur); }
#undef PG8_SA
#undef PG8_SB
#undef PG8_STAGE
#undef PG8_LDA
#undef PG8_LDB
#undef PG8_MMA
#undef PG8_WAIT_V
#undef PG8_WAIT_L
#undef PG8_BAR
#undef PG8_SCHED
}
}
#define LAS __attribute__((address_space(3)))
typedef unsigned short bf16;
typedef unsigned v4u __attribute__((ext_vector_type(4)));
typedef unsigned v2u __attribute__((ext_vector_type(2)));
typedef float f32x4 __attribute__((ext_vector_type(4)));
typedef float f32x2 __attribute__((ext_vector_type(2)));
typedef float f32x16 __attribute__((ext_vector_type(16)));
typedef short bf16x8 __attribute__((ext_vector_type(8)));

constexpr int NTHR = 512;
constexpr int D = 1024, MP = 4096, MS = 8192, M = MP + MS, DFF = 2816, DEPTH = 4;
constexpr int LDS_BYTES = 147456;
constexpr float EPS = 1e-6f;
constexpr float LOG2E = 1.4426950408889634f;

constexpr size_t MiB = 1u << 20;
constexpr size_t WS_FFNIN = 0;
constexpr size_t WS_FFNOUT = WS_FFNIN + 8ull * 5632 * 1024 * 2;
constexpr size_t WS_QKV = WS_FFNOUT + 8ull * 1024 * 2816 * 2;
constexpr size_t WS_AO = WS_QKV + 2ull * 1536 * 1024 * 2;
constexpr size_t WS_CIN = WS_AO + 2ull * 1024 * 1024 * 2;
constexpr size_t WS_COUT = WS_CIN + 3072ull * 1024 * 2;
constexpr size_t WS_HIN = WS_COUT + 1024ull * 1024 * 2;
constexpr size_t WS_HOUT = WS_HIN + 5120ull * 1024 * 2;
constexpr size_t WS_MOD = WS_HOUT + 1024ull * 1024 * 2;
constexpr size_t WS_ROPE = WS_MOD + 2 * MiB;
constexpr size_t WS_LB = WS_ROPE + MiB;
constexpr size_t WS_CK = WS_LB + MiB;
constexpr size_t WS_CV = WS_CK + 2 * MiB;
constexpr size_t WS_HN = WS_CV + 2 * MiB;
constexpr size_t WS_Z = WS_HN + 24 * MiB;
constexpr size_t WS_H = WS_Z + 120 * MiB;
constexpr size_t WS_O = WS_H + 48 * MiB;
constexpr size_t WS_OF = WS_O + 24 * MiB;
constexpr size_t WS_OB = WS_OF + 48 * MiB;
constexpr size_t WS_END = WS_OB + 48 * MiB;

constexpr size_t OUT_YS = (size_t)MP * D, OUT_K = (size_t)M * D, OUT_V = OUT_K + 16ull * 2 * 256 * 256, OUT_ST = OUT_V + 16ull * 2 * 256 * 256;

struct Params {
    const float *x_prompt, *x_sample, *cache_k, *cache_v, *state_hgrn, *c, *c_ctx, *w_ada, *b_ada, *norm_g, *w_ffn_in, *w_ffn_out,
        *w_attn_qkv, *w_attn_o, *attn_sink, *w_conv_in, *conv_w, *conv_b, *w_conv_out, *w_hgrn_in, *hgrn_lb, *hgrn_norm_g, *w_hgrn_out;
    float* out; unsigned char* ws;
};

__device__ __forceinline__ unsigned f2bf(float f) { unsigned u = __builtin_bit_cast(unsigned, f); return (u + 0x7fffu + ((u >> 16) & 1u)) >> 16; }
__device__ __forceinline__ unsigned pk2(float lo, float hi) { return f2bf(lo) | (f2bf(hi) << 16); }
__device__ __forceinline__ float bflo(unsigned u) { return __uint_as_float(u << 16); }
__device__ __forceinline__ float bfhi(unsigned u) { return __uint_as_float(u & 0xffff0000u); }
__device__ __forceinline__ float sigmoid_f(float a) { return __builtin_amdgcn_rcpf(1.f + __expf(-a)); }
__device__ __forceinline__ float silu_f(float a) { return a * sigmoid_f(a); }
__device__ __forceinline__ float wave_sum(float v) {
#pragma unroll
    for (int o = 1; o < 64; o <<= 1) v += __shfl_xor(v, o);
    return v;
}
#define LDS_WAIT() asm volatile("s_waitcnt lgkmcnt(0)" ::: "memory")

struct EpiSwiGLU {
    static constexpr bool PERM = true, AFTER_DRAIN = false;
    bf16* O;
    __device__ __forceinline__ void operator()(const pg8::f32x4 (&acc)[2][2][4][2], const pg8::Unit& u, int wr, int wc, int fr, int fq) const {
        const int row0 = u.pm * 256 + wr * 64 + fr, col0 = u.pn * 128 + wc * 32 + 8 * fq;
#pragma unroll
        for (int ai = 0; ai < 2; ++ai)
#pragma unroll
            for (int m = 0; m < 4; ++m) {
                bf16* rowp = O + (size_t)(row0 + ai * 128 + m * 16) * DFF + col0;
                const pg8::f32x4 a0 = acc[ai][0][m][0], a1 = acc[ai][0][m][1], b0 = acc[ai][1][m][0], b1 = acc[ai][1][m][1];
                v4u w;
                w.x = pg8::cvt_pk_bf16(silu_f(a0[0]) * b0[0], silu_f(a0[1]) * b0[1]); w.y = pg8::cvt_pk_bf16(silu_f(a0[2]) * b0[2], silu_f(a0[3]) * b0[3]);
                w.z = pg8::cvt_pk_bf16(silu_f(a1[0]) * b1[0], silu_f(a1[1]) * b1[1]); w.w = pg8::cvt_pk_bf16(silu_f(a1[2]) * b1[2], silu_f(a1[3]) * b1[3]);
                *(v4u*)rowp = w;
            }
    }
};
struct EpiF32 {
    static constexpr bool PERM = false, AFTER_DRAIN = false;
    float* O;
    __device__ __forceinline__ void operator()(const pg8::f32x4 (&acc)[2][2][4][2], const pg8::Unit& u, int wr, int wc, int fr, int fq) const {
        const int row0 = u.pm * 256 + wr * 64 + fr, col0 = u.pn * 256 + wc * 32 + 4 * fq;
#pragma unroll
        for (int ai = 0; ai < 2; ++ai)
#pragma unroll
            for (int m = 0; m < 4; ++m) {
                float* rowp = O + (size_t)(row0 + ai * 128 + m * 16) * D + col0;
#pragma unroll
                for (int bj = 0; bj < 2; ++bj)
#pragma unroll
                    for (int n = 0; n < 2; ++n) *(pg8::f32x4*)(rowp + bj * 128 + n * 16) = acc[ai][bj][m][n];
            }
    }
};
struct EpiZ {
    static constexpr bool PERM = true, AFTER_DRAIN = false;
    bf16* O; int ldc; float* kout; float* vout;
    __device__ __forceinline__ void operator()(const pg8::f32x4 (&acc)[2][2][4][2], const pg8::Unit& u, int wr, int wc, int fr, int fq) const {
        const int row0 = u.pm * 256 + wr * 64 + fr, col0 = u.pn * 256 + wc * 32 + 8 * fq;
        const bool kv = (kout != nullptr) && u.pn >= 4 && u.pm < 16;
        float* kvb = (u.pn == 4) ? kout : vout;
#pragma unroll
        for (int ai = 0; ai < 2; ++ai)
#pragma unroll
            for (int m = 0; m < 4; ++m) {
                const int row = row0 + ai * 128 + m * 16;
                bf16* rowp = O + (size_t)row * ldc + col0;
#pragma unroll
                for (int bj = 0; bj < 2; ++bj) {
                    const pg8::f32x4 v0 = acc[ai][bj][m][0], v1 = acc[ai][bj][m][1];
                    v4u w; w.x = pg8::cvt_pk_bf16(v0[0], v0[1]); w.y = pg8::cvt_pk_bf16(v0[2], v0[3]); w.z = pg8::cvt_pk_bf16(v1[0], v1[1]); w.w = pg8::cvt_pk_bf16(v1[2], v1[3]);
                    *(v4u*)(rowp + bj * 128) = w;
                    if (kv) { float* dst = kvb + (size_t)(row >> 8) * (2 * 65536) + (size_t)(row & 255) * 256 + wc * 32 + 8 * fq + bj * 128;
                        *(pg8::f32x4*)dst = v0; *(pg8::f32x4*)(dst + 4) = v1; }
                }
            }
    }
};
__device__ __forceinline__ void p0_transpose_item(const float* W, int K, int N, bf16* WT, int k0, int n0, int drow0, LAS float* scr, int lane) {
#pragma unroll 8
    for (int i = 0; i < 32; ++i) { const int kk = 2 * i + (lane >> 5); scr[kk * 33 + (lane & 31)] = W[(size_t)(k0 + kk) * N + n0 + (lane & 31)]; }
    LDS_WAIT(); asm volatile("" ::: "memory");
    const int c = lane & 7;
#pragma unroll
    for (int j = 0; j < 4; ++j) { const int n = (lane >> 3) + 8 * j; const LAS float* s = scr + (8 * c) * 33 + n;
        v4u o; o.x = pk2(s[0 * 33], s[1 * 33]); o.y = pk2(s[2 * 33], s[3 * 33]); o.z = pk2(s[4 * 33], s[5 * 33]); o.w = pk2(s[6 * 33], s[7 * 33]);
        *(v4u*)(WT + (size_t)(drow0 + n) * K + k0 + 8 * c) = o; }
    LDS_WAIT(); asm volatile("" ::: "memory");
}

constexpr int IT_FI = 16 * 176, IT_FO = 44 * 32, IT_QKV = 16 * 48, IT_SQ = 16 * 32, IT_CI = 16 * 96, IT_HI = 16 * 160;
constexpr int C0 = 8 * IT_FI, C1 = C0 + 8 * IT_FO, C2 = C1 + 2 * IT_QKV, C3 = C2 + 2 * IT_SQ, C4 = C3 + IT_CI, C5 = C4 + IT_SQ, C6 = C5 + IT_HI, C7 = C6 + IT_SQ;

__device__ __forceinline__ void p0_prologue(const Params& p, LAS unsigned char* lds) {
    const int tid = opaque_tid(), lane = tid & 63, wave = __builtin_amdgcn_readfirstlane(tid >> 6);
    const int gt = blockIdx.x * NTHR + tid, NGT = gridDim.x * NTHR;
    const int gw = blockIdx.x * 8 + wave, NGW = gridDim.x * 8;
    { float* cs = (float*)(p.ws + WS_ROPE); float* sn = cs + 1024 * 32;
      for (int i = gt; i < 1024 * 32; i += NGT) { const int t = i >> 5, k = i & 31; const float pos = (float)(k < 16 ? (t >> 6) : (t & 63));
          const float inv = exp2f(-(float)(k & 15) * (13.287712379549449f / 16.0f));
          const float ang = pos * inv; cs[i] = __cosf(ang); sn[i] = __sinf(ang); } }
    { float* lbt = (float*)(p.ws + WS_LB);
      for (int i = gt; i < 2048; i += NGT) { const int dir = i >> 10, d = i & 1023; const float* q = p.hgrn_lb + (size_t)dir * DEPTH * 1024 + d;
          const float a0 = q[0], a1 = q[1024], a2 = q[2048], a3 = q[3072]; const float mx = fmaxf(fmaxf(a0, a1), fmaxf(a2, a3));
          const float e0 = expf(a0 - mx), e1 = expf(a1 - mx), e2 = expf(a2 - mx), e3 = expf(a3 - mx);
          lbt[i] = (e1 + e2) / (e0 + e1 + e2 + e3); } }
    { bf16* ck = (bf16*)(p.ws + WS_CK); bf16* cv = (bf16*)(p.ws + WS_CV);
      for (int i = gt; i < 8 * 2 * 256 * 256 / 4; i += NGT) { const f32x4 a = ((const f32x4*)p.cache_k)[i], b = ((const f32x4*)p.cache_v)[i];
          v2u wa, wb; wa.x = pk2(a.x, a.y); wa.y = pk2(a.z, a.w); wb.x = pk2(b.x, b.y); wb.y = pk2(b.z, b.w);
          ((v2u*)ck)[i] = wa; ((v2u*)cv)[i] = wb; } }
    { LAS float* sc = (LAS float*)lds;
      LAS float* red = (LAS float*)(lds + 49152);
      for (int i = tid; i < 9 * 1024; i += NTHR) { const int cnd = i >> 10, k = i & 1023; const float v = cnd == 0 ? p.c_ctx[k] : p.c[(cnd - 1) * 1024 + k]; sc[k * 12 + cnd] = v / (1.f + expf(-v)); }
      __syncthreads();
      float* mod = (float*)(p.ws + WS_MOD);
      for (int task = blockIdx.x; task < 288; task += gridDim.x) {
          const int li = task / 72, cgp = task % 72;
          const float* W = p.w_ada + (size_t)li * 1024 * 9216 + cgp * 128 + 2 * lane;
          float a0[9], a1[9];
#pragma unroll
          for (int q = 0; q < 9; ++q) { a0[q] = 0.f; a1[q] = 0.f; }
          const int k0 = wave * 128;
#pragma unroll 8
          for (int k = k0; k < k0 + 128; ++k) {
              const f32x2 w = *(const f32x2*)(W + (size_t)k * 9216);
              const f32x4 s0 = *(const LAS f32x4*)(sc + k * 12), s1 = *(const LAS f32x4*)(sc + k * 12 + 4), s2 = *(const LAS f32x4*)(sc + k * 12 + 8);
              a0[0] += s0.x * w.x; a1[0] += s0.x * w.y; a0[1] += s0.y * w.x; a1[1] += s0.y * w.y; a0[2] += s0.z * w.x; a1[2] += s0.z * w.y; a0[3] += s0.w * w.x; a1[3] += s0.w * w.y;
              a0[4] += s1.x * w.x; a1[4] += s1.x * w.y; a0[5] += s1.y * w.x; a1[5] += s1.y * w.y; a0[6] += s1.z * w.x; a1[6] += s1.z * w.y; a0[7] += s1.w * w.x; a1[7] += s1.w * w.y;
              a0[8] += s2.x * w.x; a1[8] += s2.x * w.y;
          }
#pragma unroll
          for (int q = 0; q < 9; ++q) *(LAS f32x2*)(red + (wave * 9 + q) * 128 + 2 * lane) = (f32x2){a0[q], a1[q]};
          __syncthreads();
          for (int i = tid; i < 9 * 128; i += NTHR) { const int q = i >> 7, cc = i & 127; float s = 0.f;
#pragma unroll
              for (int w8 = 0; w8 < 8; ++w8) s += red[(w8 * 9 + q) * 128 + cc];
              const int col = cgp * 128 + cc; mod[((size_t)li * 9 + q) * 9216 + col] = s + p.b_ada[li * 9216 + col]; }
          __syncthreads();
      }
    }
    { LAS float* scr = (LAS float*)(lds + wave * 16384);
      for (int it = gw; it < C7; it += NGW) {
          const float* W; bf16* WT; int K, N, r; bool swi = false;
          if (it < C0) { const int mi = it / IT_FI; r = it % IT_FI; W = p.w_ffn_in + (size_t)mi * 1024 * 5632; WT = (bf16*)(p.ws + WS_FFNIN) + (size_t)mi * 5632 * 1024; K = 1024; N = 5632; swi = true; }
          else if (it < C1) { const int q = it - C0, mi = q / IT_FO; r = q % IT_FO; W = p.w_ffn_out + (size_t)mi * 2816 * 1024; WT = (bf16*)(p.ws + WS_FFNOUT) + (size_t)mi * 1024 * 2816; K = 2816; N = 1024; }
          else if (it < C2) { const int q = it - C1, mi = q / IT_QKV; r = q % IT_QKV; W = p.w_attn_qkv + (size_t)mi * 1024 * 1536; WT = (bf16*)(p.ws + WS_QKV) + (size_t)mi * 1536 * 1024; K = 1024; N = 1536; }
          else if (it < C3) { const int q = it - C2, mi = q / IT_SQ; r = q % IT_SQ; W = p.w_attn_o + (size_t)mi * 1024 * 1024; WT = (bf16*)(p.ws + WS_AO) + (size_t)mi * 1024 * 1024; K = 1024; N = 1024; }
          else if (it < C4) { r = it - C3; W = p.w_conv_in; WT = (bf16*)(p.ws + WS_CIN); K = 1024; N = 3072; }
          else if (it < C5) { r = it - C4; W = p.w_conv_out; WT = (bf16*)(p.ws + WS_COUT); K = 1024; N = 1024; }
          else if (it < C6) { r = it - C5; W = p.w_hgrn_in; WT = (bf16*)(p.ws + WS_HIN); K = 1024; N = 5120; }
          else { r = it - C6; W = p.w_hgrn_out; WT = (bf16*)(p.ws + WS_HOUT); K = 1024; N = 1024; }
          const int nblk = N / 32, kb = r / nblk, nb = r % nblk, n0 = 32 * nb;
          int drow0 = n0;
          if (swi) { drow0 = n0 < DFF ? (n0 / 128) * 256 + (n0 % 128) : ((n0 - DFF) / 128) * 256 + 128 + ((n0 - DFF) % 128); }
          p0_transpose_item(W, K, N, WT, 64 * kb, n0, drow0, scr, lane);
      }
    }
}

__device__ __forceinline__ void ew_phase(const Params& p, bool first, bool has_next, float res_scale,
                                         const float* modh, int gate_idx, const float* g_post, const float* modn, int sub_next, const float* g_pre) {
    const int tid = opaque_tid(), lane = tid & 63, wave = __builtin_amdgcn_readfirstlane(tid >> 6);
    const float* hbuf = (const float*)(p.ws + WS_H); bf16* hn = (bf16*)(p.ws + WS_HN);
    for (int m = blockIdx.x * 8 + wave; m < M; m += gridDim.x * 8) {
        const int cond = m < MP ? 0 : 1 + ((m - MP) >> 10);
        float* xo = p.out + (size_t)m * D;
        f32x4 x[4];
        if (first) { const f32x4* xi = (const f32x4*)(m < MP ? p.x_prompt + (size_t)m * D : p.x_sample + (size_t)(m - MP) * D) + lane;
#pragma unroll
            for (int j = 0; j < 4; ++j) x[j] = xi[64 * j];
        } else {
            const f32x4* xi = (const f32x4*)xo + lane; const f32x4* hi = (const f32x4*)(hbuf + (size_t)m * D) + lane;
            const f32x4* gt = (const f32x4*)(modh + (size_t)cond * 9216 + gate_idx * 1024) + lane; const f32x4* gp = (const f32x4*)g_post + lane;
            f32x4 h[4]; float ss = 0.f;
#pragma unroll
            for (int j = 0; j < 4; ++j) { h[j] = hi[64 * j]; x[j] = xi[64 * j]; ss += (h[j].x * h[j].x + h[j].y * h[j].y) + (h[j].z * h[j].z + h[j].w * h[j].w); }
            const float rs = res_scale * rsqrtf(wave_sum(ss) * (1.f / D) + EPS);
#pragma unroll
            for (int j = 0; j < 4; ++j) { const f32x4 g = gt[64 * j], q = gp[64 * j]; x[j] = x[j] + (h[j] * rs) * (g * q); }
        }
        { f32x4* xw = (f32x4*)xo + lane;
#pragma unroll
          for (int j = 0; j < 4; ++j) xw[64 * j] = x[j]; }
        if (has_next) {
            float ss = 0.f;
#pragma unroll
            for (int j = 0; j < 4; ++j) ss += (x[j].x * x[j].x + x[j].y * x[j].y) + (x[j].z * x[j].z + x[j].w * x[j].w);
            const float rs = rsqrtf(wave_sum(ss) * (1.f / D) + EPS);
            const f32x4* sh = (const f32x4*)(modn + (size_t)cond * 9216 + (3 * sub_next) * 1024) + lane; const f32x4* sc = (const f32x4*)(modn + (size_t)cond * 9216 + (3 * sub_next + 1) * 1024) + lane;
            const f32x4* gp = (const f32x4*)g_pre + lane;
            v2u* o8 = (v2u*)(hn + (size_t)m * D) + lane;
#pragma unroll
            for (int j = 0; j < 4; ++j) { const f32x4 g = gp[64 * j], s = sc[64 * j], t = sh[64 * j]; const f32x4 y = (x[j] * rs) * g * (s + 1.f) + t;
                v2u w; w.x = pk2(y.x, y.y); w.y = pk2(y.z, y.w); o8[64 * j] = w; }
        }
    }
}

__device__ __forceinline__ void conv_phase(const Params& p) {
    const int tid = opaque_tid(), lane = tid & 63, wave = __builtin_amdgcn_readfirstlane(tid >> 6);
    const bf16* z = (const bf16*)(p.ws + WS_Z); bf16* o = (bf16*)(p.ws + WS_O);
    for (int m = blockIdx.x * 8 + wave; m < M; m += gridDim.x * 8) {
        const int tpos = m < MP ? (m & 255) : ((m - MP) & 1023), L = m < MP ? 256 : 1024;
        const bool hp = tpos > 0, hx = tpos < L - 1;
        const bf16* zr = z + (size_t)m * 3072;
#pragma unroll
        for (int jj = 0; jj < 2; ++jj) {
            const int c0 = 8 * lane + 512 * jj;
            const v4u bg = *(const v4u*)(zr + c0), cg1 = *(const v4u*)(zr + 1024 + c0), u1 = *(const v4u*)(zr + 2048 + c0);
            v4u cg0 = (v4u){0u, 0u, 0u, 0u}, u0 = cg0, cg2 = cg0, u2 = cg0;
            if (hp) { cg0 = *(const v4u*)(zr - 3072 + 1024 + c0); u0 = *(const v4u*)(zr - 3072 + 2048 + c0); }
            if (hx) { cg2 = *(const v4u*)(zr + 3072 + 1024 + c0); u2 = *(const v4u*)(zr + 3072 + 2048 + c0); }
            const f32x4 w0a = *(const f32x4*)(p.conv_w + c0), w0b = *(const f32x4*)(p.conv_w + c0 + 4), w1a = *(const f32x4*)(p.conv_w + 1024 + c0), w1b = *(const f32x4*)(p.conv_w + 1024 + c0 + 4),
                        w2a = *(const f32x4*)(p.conv_w + 2048 + c0), w2b = *(const f32x4*)(p.conv_w + 2048 + c0 + 4), cba = *(const f32x4*)(p.conv_b + c0), cbb = *(const f32x4*)(p.conv_b + c0 + 4);
            float w0[8] = {w0a.x, w0a.y, w0a.z, w0a.w, w0b.x, w0b.y, w0b.z, w0b.w}, w1[8] = {w1a.x, w1a.y, w1a.z, w1a.w, w1b.x, w1b.y, w1b.z, w1b.w},
                  w2[8] = {w2a.x, w2a.y, w2a.z, w2a.w, w2b.x, w2b.y, w2b.z, w2b.w}, cb[8] = {cba.x, cba.y, cba.z, cba.w, cbb.x, cbb.y, cbb.z, cbb.w};
            float r[8];
#pragma unroll
            for (int e = 0; e < 4; ++e) {
                const float z0l = bflo(cg0[e]) * bflo(u0[e]), z0h = bfhi(cg0[e]) * bfhi(u0[e]), z1l = bflo(cg1[e]) * bflo(u1[e]), z1h = bfhi(cg1[e]) * bfhi(u1[e]),
                            z2l = bflo(cg2[e]) * bflo(u2[e]), z2h = bfhi(cg2[e]) * bfhi(u2[e]);
                r[2 * e] = bflo(bg[e]) * (cb[2 * e] + w0[2 * e] * z0l + w1[2 * e] * z1l + w2[2 * e] * z2l);
                r[2 * e + 1] = bfhi(bg[e]) * (cb[2 * e + 1] + w0[2 * e + 1] * z0h + w1[2 * e + 1] * z1h + w2[2 * e + 1] * z2h);
            }
            v4u w; w.x = pk2(r[0], r[1]); w.y = pk2(r[2], r[3]); w.z = pk2(r[4], r[5]); w.w = pk2(r[6], r[7]);
            *(v4u*)(o + (size_t)m * D + c0) = w;
        }
    }
}
__device__ __forceinline__ int crow(int r, int h) { return (r & 3) + 8 * (r >> 2) + 4 * h; }
__device__ __forceinline__ void attn_phase(const Params& p, LAS unsigned char* lds, int j) {
    const int tid = opaque_tid(), lane = tid & 63, wave = __builtin_amdgcn_readfirstlane(tid >> 6);
    const bf16* z = (const bf16*)(p.ws + WS_Z); bf16* o = (bf16*)(p.ws + WS_O);
    const bf16* ck = (const bf16*)(p.ws + WS_CK); const bf16* cv = (const bf16*)(p.ws + WS_CV);
    const float* cs = (const float*)(p.ws + WS_ROPE); const float* sn = cs + 1024 * 32;
    LAS bf16* Ks = (LAS bf16*)lds;
    LAS bf16* Vt = (LAS bf16*)(lds + 32 * 72 * 2);
    const int half = lane >> 5, n = lane & 31, g = wave >> 1, qs = wave & 1;
    for (int u = blockIdx.x; u < 768; u += gridDim.x) {
        const bool smp = u < 512;
        int b, kvh, qb, row0;
        if (smp) { b = u >> 6; kvh = (u >> 4) & 3; qb = u & 15; row0 = MP + b * 1024; }
        else { const int r = u - 512; b = r >> 4; kvh = (r >> 2) & 3; qb = r & 3; row0 = b * 256; }
        const int head = kvh * 4 + g, qpos = qb * 64 + qs * 32 + n;
        bf16x8 qf[4];
        { const bf16* qrow = z + (size_t)(row0 + qpos) * 1536 + head * 64 + 8 * half;
          float q[4][8];
#pragma unroll
          for (int ks = 0; ks < 4; ++ks) { const v4u r = *(const v4u*)(qrow + 16 * ks);
#pragma unroll
              for (int e = 0; e < 4; ++e) { q[ks][2 * e] = bflo(r[e]); q[ks][2 * e + 1] = bfhi(r[e]); } }
          if (smp) {
#pragma unroll
              for (int ks = 0; ks < 2; ++ks) { const float* cp = cs + qpos * 32 + 16 * ks + 8 * half; const float* sp = sn + qpos * 32 + 16 * ks + 8 * half;
                  const f32x4 c0 = *(const f32x4*)cp, c1 = *(const f32x4*)(cp + 4), s0 = *(const f32x4*)sp, s1 = *(const f32x4*)(sp + 4);
                  const float cc[8] = {c0.x, c0.y, c0.z, c0.w, c1.x, c1.y, c1.z, c1.w}, ss[8] = {s0.x, s0.y, s0.z, s0.w, s1.x, s1.y, s1.z, s1.w};
#pragma unroll
                  for (int e = 0; e < 8; ++e) { const float x1 = q[ks][e], x2 = q[ks + 2][e]; q[ks][e] = x1 * cc[e] - x2 * ss[e]; q[ks + 2][e] = x1 * ss[e] + x2 * cc[e]; } }
          }
          const float qsc = 0.125f * LOG2E;
#pragma unroll
          for (int ks = 0; ks < 4; ++ks) { v4u w;
#pragma unroll
              for (int e = 0; e < 4; ++e) w[e] = pk2(q[ks][2 * e] * qsc, q[ks][2 * e + 1] * qsc);
              qf[ks] = __builtin_bit_cast(bf16x8, w); }
        }
        float m_run = p.attn_sink[j * 16 + head] * LOG2E, l_run = 1.f;
        f32x16 O0, O1;
#pragma unroll
        for (int i = 0; i < 16; ++i) { O0[i] = 0.f; O1[i] = 0.f; }
        int lat_lo = 0, lat_n = 8;
        if (smp) { const int lo = max(0, qb * 64 - 128), hi = min(1024, qb * 64 + 192); lat_lo = lo; lat_n = (hi - lo) >> 5; }
        const int ntile = lat_n + (smp ? 8 : 0);
        for (int t = 0; t < ntile; ++t) {
            const bool is_lat = t < lat_n;
            const bf16 *kbase, *vbase; int pitch, kstart;
            if (is_lat) { kstart = lat_lo + 32 * t; kbase = z + (size_t)(row0 + kstart) * 1536 + 1024 + kvh * 64; vbase = kbase + 256; pitch = 1536; }
            else { kstart = 32 * (t - lat_n); kbase = ck + (size_t)((b * 2 + j) * 256 + kstart) * 256 + kvh * 64; vbase = cv + (size_t)((b * 2 + j) * 256 + kstart) * 256 + kvh * 64; pitch = 256; }
            __syncthreads();
            { const int key = tid >> 4, c = tid & 15;
              const bf16* kr = kbase + (size_t)key * pitch;
              unsigned lo = *(const unsigned*)(kr + 2 * c), hi = *(const unsigned*)(kr + 32 + 2 * c);
              if (smp && is_lat) { const int kp = kstart + key; const f32x2 c2 = *(const f32x2*)(cs + kp * 32 + 2 * c), s2 = *(const f32x2*)(sn + kp * 32 + 2 * c);
                  const float x1a = bflo(lo), x1b = bfhi(lo), x2a = bflo(hi), x2b = bfhi(hi);
                  lo = pk2(x1a * c2.x - x2a * s2.x, x1b * c2.y - x2b * s2.y); hi = pk2(x1a * s2.x + x2a * c2.x, x1b * s2.y + x2b * c2.y); }
              *(LAS unsigned*)(Ks + key * 72 + 2 * c) = lo; *(LAS unsigned*)(Ks + key * 72 + 32 + 2 * c) = hi;
              const v2u vv = *(const v2u*)(vbase + (size_t)key * pitch + 4 * c);
              Vt[(4 * c + 0) * 40 + key] = (bf16)(vv.x & 0xffffu); Vt[(4 * c + 1) * 40 + key] = (bf16)(vv.x >> 16);
              Vt[(4 * c + 2) * 40 + key] = (bf16)(vv.y & 0xffffu); Vt[(4 * c + 3) * 40 + key] = (bf16)(vv.y >> 16); }
            __syncthreads();
            f32x16 S;
#pragma unroll
            for (int i = 0; i < 16; ++i) S[i] = 0.f;
#pragma unroll
            for (int ks = 0; ks < 4; ++ks) { const bf16x8 a = *(const LAS bf16x8*)(Ks + n * 72 + 16 * ks + 8 * half); S = __builtin_amdgcn_mfma_f32_32x32x16_bf16(a, qf[ks], S, 0, 0, 0); }
            if (smp && is_lat) {
#pragma unroll
                for (int i = 0; i < 16; ++i) { const int dd = qpos - (kstart + crow(i, half)); if (dd > 128 || dd < -128) S[i] = -INFINITY; }
            }
            float mx = S[0];
#pragma unroll
            for (int i = 1; i < 16; ++i) mx = fmaxf(mx, S[i]);
            mx = fmaxf(mx, __shfl_xor(mx, 32));
            const float m_new = fmaxf(m_run, mx), alpha = __builtin_amdgcn_exp2f(m_run - m_new);
            float rs = 0.f;
#pragma unroll
            for (int i = 0; i < 16; ++i) { S[i] = __builtin_amdgcn_exp2f(S[i] - m_new); rs += S[i]; }
            rs += __shfl_xor(rs, 32);
            l_run = l_run * alpha + rs; m_run = m_new;
#pragma unroll
            for (int i = 0; i < 16; ++i) { O0[i] *= alpha; O1[i] *= alpha; }
            bf16x8 pb[2];
#pragma unroll
            for (int t2 = 0; t2 < 2; ++t2) { v4u w;
#pragma unroll
                for (int e = 0; e < 4; ++e) w[e] = pk2(S[8 * t2 + 2 * e], S[8 * t2 + 2 * e + 1]);
                pb[t2] = __builtin_bit_cast(bf16x8, w); }
#pragma unroll
            for (int t2 = 0; t2 < 2; ++t2) {
                { const LAS bf16* vp = Vt + n * 40 + 16 * t2 + 4 * half; const v2u lo = *(const LAS v2u*)vp, hi = *(const LAS v2u*)(vp + 8);
                  const v4u a = (v4u){lo.x, lo.y, hi.x, hi.y}; O0 = __builtin_amdgcn_mfma_f32_32x32x16_bf16(__builtin_bit_cast(bf16x8, a), pb[t2], O0, 0, 0, 0); }
                { const LAS bf16* vp = Vt + (32 + n) * 40 + 16 * t2 + 4 * half; const v2u lo = *(const LAS v2u*)vp, hi = *(const LAS v2u*)(vp + 8);
                  const v4u a = (v4u){lo.x, lo.y, hi.x, hi.y}; O1 = __builtin_amdgcn_mfma_f32_32x32x16_bf16(__builtin_bit_cast(bf16x8, a), pb[t2], O1, 0, 0, 0); }
            }
        }
        const float inv = 1.f / l_run;
        bf16* orow = o + (size_t)(row0 + qpos) * D + head * 64 + 4 * half;
#pragma unroll
        for (int gq = 0; gq < 4; ++gq) {
            v2u w0, w1; w0.x = pk2(O0[4 * gq] * inv, O0[4 * gq + 1] * inv); w0.y = pk2(O0[4 * gq + 2] * inv, O0[4 * gq + 3] * inv);
            w1.x = pk2(O1[4 * gq] * inv, O1[4 * gq + 1] * inv); w1.y = pk2(O1[4 * gq + 2] * inv, O1[4 * gq + 3] * inv);
            *(v2u*)(orow + 8 * gq) = w0; *(v2u*)(orow + 32 + 8 * gq) = w1;
        }
    }
}

__device__ __forceinline__ void scan_phase(const Params& p, LAS unsigned char* lds) {
    const int tid = opaque_tid(), lane = tid & 63, wave = __builtin_amdgcn_readfirstlane(tid >> 6);
    const bf16* z = (const bf16*)(p.ws + WS_Z);
    const float* lbt = (const float*)(p.ws + WS_LB);
    const int st = tid >> 5, c4 = (tid & 31) * 4, c2 = (tid & 31) * 2;
    for (int it = blockIdx.x; it < 768; it += gridDim.x) {
        const bool smp = it < 256; const int r = smp ? it : it - 256;
        const int half = r & 1, dir = (r >> 1) & 1, h = (r >> 2) & 7, b = r >> 5;
        const int L = smp ? 1024 : 256, row0 = smp ? MP + b * 1024 : b * 256;
        float* og = (float*)(p.ws + (dir ? WS_OB : WS_OF));
        float S[16];
        if (smp) { const float* s0 = p.state_hgrn + ((size_t)((b * 2 + dir) * 8 + h) * 128 + 16 * wave) * 128 + half * 64 + lane;
#pragma unroll
            for (int jj = 0; jj < 16; ++jj) S[jj] = s0[jj * 128];
        } else {
#pragma unroll
            for (int jj = 0; jj < 16; ++jj) S[jj] = 0.f;
        }
        const int colq = h * 128 + c4;
        const f32x4 lb4 = *(const f32x4*)(lbt + dir * 1024 + colq);
        const int nchunk = L >> 4;
        v2u rq, rf; unsigned rv;
#define SCAN_LOAD(c) do { const int tp_ = dir ? (L - 1 - ((c) * 16 + st)) : ((c) * 16 + st); const bf16* zr_ = z + (size_t)(row0 + tp_) * 5120; \
        rq = *(const v2u*)(zr_ + colq); rf = *(const v2u*)(zr_ + 2048 + dir * 1024 + colq); rv = *(const unsigned*)(zr_ + 1024 + h * 128 + half * 64 + c2); } while (0)
#define SCAN_STORE(bufi) do { LAS float* B_ = (LAS float*)(lds + (bufi) * 28672); \
        f32x4 q_, f_, k_; const float zq_[4] = {bflo(rq.x), bfhi(rq.x), bflo(rq.y), bfhi(rq.y)}, zf_[4] = {bflo(rf.x), bfhi(rf.x), bflo(rf.y), bfhi(rf.y)}; \
        _Pragma("unroll") for (int e_ = 0; e_ < 4; ++e_) { q_[e_] = silu_f(zq_[e_]) * 0.08838834764831845f; const float fv_ = lb4[e_] + (1.f - lb4[e_]) * sigmoid_f(zf_[e_]); f_[e_] = fv_; k_[e_] = 1.f - fv_; } \
        *(LAS f32x4*)(B_ + st * 128 + c4) = q_; *(LAS f32x4*)(B_ + 2048 + st * 128 + c4) = k_; *(LAS f32x4*)(B_ + 4096 + st * 128 + c4) = f_; \
        *(LAS f32x2*)(B_ + 6144 + st * 64 + c2) = (f32x2){bflo(rv), bfhi(rv)}; } while (0)
        SCAN_LOAD(0); SCAN_STORE(0);
        __syncthreads();
        for (int c = 0; c < nchunk; ++c) {
            const bool more = c + 1 < nchunk;
            if (more) SCAN_LOAD(c + 1);
            const LAS float* B = (const LAS float*)(lds + (c & 1) * 28672);
            LAS float* red = (LAS float*)(lds + 57344 + (c & 1) * 32768);
#pragma unroll
            for (int s2 = 0; s2 < 16; ++s2) {
                const float vv = B[6144 + s2 * 64 + lane];
                float acc = 0.f;
#pragma unroll
                for (int i4 = 0; i4 < 4; ++i4) {
                    const f32x4 q4 = *(const LAS f32x4*)(B + s2 * 128 + 16 * wave + 4 * i4), k4 = *(const LAS f32x4*)(B + 2048 + s2 * 128 + 16 * wave + 4 * i4), f4 = *(const LAS f32x4*)(B + 4096 + s2 * 128 + 16 * wave + 4 * i4);
#pragma unroll
                    for (int e = 0; e < 4; ++e) { const float sn_ = f4[e] * S[4 * i4 + e] + k4[e] * vv; S[4 * i4 + e] = sn_; acc += sn_ * q4[e]; }
                }
                red[(wave * 16 + s2) * 64 + lane] = acc;
            }
            if (more) SCAN_STORE((c + 1) & 1);
            __syncthreads();
            { float s0 = 0.f, s1 = 0.f;
#pragma unroll
              for (int w8 = 0; w8 < 8; ++w8) { const f32x2 t2 = *(const LAS f32x2*)(red + (w8 * 16 + st) * 64 + c2); s0 += t2.x; s1 += t2.y; }
              const int tp = dir ? (L - 1 - (c * 16 + st)) : (c * 16 + st);
              *(f32x2*)(og + (size_t)(row0 + tp) * D + h * 128 + half * 64 + c2) = (f32x2){s0, s1}; }
        }
#undef SCAN_LOAD
#undef SCAN_STORE
        if (!smp) { float* so = p.out + OUT_ST + ((size_t)((b * 2 + dir) * 8 + h) * 128 + 16 * wave) * 128 + half * 64 + lane;
#pragma unroll
            for (int jj = 0; jj < 16; ++jj) so[jj * 128] = S[jj]; }
        __syncthreads();
    }
}
__device__ __forceinline__ void hgate_phase(const Params& p) {
    const int tid = opaque_tid(), lane = tid & 63, wave = __builtin_amdgcn_readfirstlane(tid >> 6);
    const bf16* z = (const bf16*)(p.ws + WS_Z); bf16* o = (bf16*)(p.ws + WS_O);
    const float* of = (const float*)(p.ws + WS_OF); const float* ob = (const float*)(p.ws + WS_OB);
    for (int m = blockIdx.x * 8 + wave; m < M; m += gridDim.x * 8) {
        const f32x4* a = (const f32x4*)(of + (size_t)m * D + 16 * lane); const f32x4* bq = (const f32x4*)(ob + (size_t)m * D + 16 * lane);
        f32x4 v[4]; float ss = 0.f;
#pragma unroll
        for (int jj = 0; jj < 4; ++jj) { v[jj] = a[jj] + bq[jj]; ss += (v[jj].x * v[jj].x + v[jj].y * v[jj].y) + (v[jj].z * v[jj].z + v[jj].w * v[jj].w); }
        ss += __shfl_xor(ss, 1); ss += __shfl_xor(ss, 2); ss += __shfl_xor(ss, 4);
        const float rs = rsqrtf(ss * (1.f / 128.f) + EPS);
        const v4u g0 = *(const v4u*)(z + (size_t)m * 5120 + 4096 + 16 * lane), g1 = *(const v4u*)(z + (size_t)m * 5120 + 4096 + 16 * lane + 8);
        const f32x4* ng = (const f32x4*)(p.hgrn_norm_g + ((16 * lane) & 127));
        float r[16];
#pragma unroll
        for (int jj = 0; jj < 4; ++jj) { const f32x4 gg = ng[jj]; const unsigned ga = jj < 2 ? g0[2 * jj] : g1[2 * jj - 4], gb = jj < 2 ? g0[2 * jj + 1] : g1[2 * jj - 3];
            r[4 * jj] = v[jj].x * rs * gg.x * silu_f(bflo(ga)); r[4 * jj + 1] = v[jj].y * rs * gg.y * silu_f(bfhi(ga));
            r[4 * jj + 2] = v[jj].z * rs * gg.z * silu_f(bflo(gb)); r[4 * jj + 3] = v[jj].w * rs * gg.w * silu_f(bfhi(gb)); }
        v4u w0, w1; w0.x = pk2(r[0], r[1]); w0.y = pk2(r[2], r[3]); w0.z = pk2(r[4], r[5]); w0.w = pk2(r[6], r[7]);
        w1.x = pk2(r[8], r[9]); w1.y = pk2(r[10], r[11]); w1.z = pk2(r[12], r[13]); w1.w = pk2(r[14], r[15]);
        *(v4u*)(o + (size_t)m * D + 16 * lane) = w0; *(v4u*)(o + (size_t)m * D + 16 * lane + 8) = w1;
    }
}
__global__ void __launch_bounds__(NTHR, 2) fwd_megakernel(Params p) {
    extern __shared__ __attribute__((aligned(16))) unsigned char lds_raw[];
    cg::grid_group grid = cg::this_grid();
    LAS unsigned char* lds = (LAS unsigned char*)lds_raw;
    const int G = gridDim.x;
    const float* mod = (const float*)(p.ws + WS_MOD);
    bf16* hn = (bf16*)(p.ws + WS_HN); bf16* zb = (bf16*)(p.ws + WS_Z); float* hb = (float*)(p.ws + WS_H); bf16* ob = (bf16*)(p.ws + WS_O);

    p0_prologue(p, lds);
    grid.sync();

#pragma unroll 1
    for (int li = 0; li < DEPTH; ++li) {
        const int kind = li % 3, jm = li / 3;
        const float* modl = mod + (size_t)li * 9 * 9216;
        const float* ng = p.norm_g + (size_t)li * 6 * 1024;
#pragma unroll 1
        for (int sub = 0; sub < 3; ++sub) {
            {
                const bool first = (li == 0 && sub == 0);
                const float* modh; const float* gpost; int gate_idx; float rscale;
                if (sub == 0) { modh = modl - 9 * 9216; gpost = ng - 6 * 1024 + 5 * 1024; gate_idx = 8; rscale = 0.5f; if (first) { modh = modl; gpost = ng; } }
                else if (sub == 1) { modh = modl; gpost = ng + 1 * 1024; gate_idx = 2; rscale = 0.5f; }
                else { modh = modl; gpost = ng + 3 * 1024; gate_idx = 5; rscale = 1.0f; }
                ew_phase(p, first, true, rscale, modh, gate_idx, gpost, modl, sub, ng + 2 * sub * 1024);
            }
            grid.sync();
            const bf16* A2; const bf16* B2; int K2;
            if (sub != 1) {
                const int wi = li * 2 + (sub >> 1);
                pg8::Gemm g{hn, (const bf16*)(p.ws + WS_FFNIN) + (size_t)wi * 5632 * 1024, M, 5632, 1024}; pg8::StaticOrder S; S.init(M, 5632, G, (int)blockIdx.x);
                EpiSwiGLU E{zb};
                pg8::gemm_phase<EpiSwiGLU, pg8::StaticOrder, true, true>(lds, g, S, E);
                grid.sync();
                A2 = zb; B2 = (const bf16*)(p.ws + WS_FFNOUT) + (size_t)wi * 1024 * 2816; K2 = 2816;
            } else {
                const bf16* Bi; int Ni; float* kout = nullptr; float* vout = nullptr;
                if (kind == 0) { Bi = (const bf16*)(p.ws + WS_QKV) + (size_t)jm * 1536 * 1024; Ni = 1536; kout = p.out + OUT_K + (size_t)jm * 65536; vout = p.out + OUT_V + (size_t)jm * 65536; B2 = (const bf16*)(p.ws + WS_AO) + (size_t)jm * 1024 * 1024; }
                else if (kind == 1) { Bi = (const bf16*)(p.ws + WS_CIN); Ni = 3072; B2 = (const bf16*)(p.ws + WS_COUT); }
                else { Bi = (const bf16*)(p.ws + WS_HIN); Ni = 5120; B2 = (const bf16*)(p.ws + WS_HOUT); }
                {
                    pg8::Gemm g{hn, Bi, M, Ni, 1024}; pg8::StaticOrder S; S.init(M, Ni, G, (int)blockIdx.x);
                    EpiZ E{zb, Ni, kout, vout};
                    pg8::gemm_phase<EpiZ, pg8::StaticOrder, true, true>(lds, g, S, E);
                }
                grid.sync();
                if (kind == 0) attn_phase(p, lds, jm);
                else if (kind == 1) conv_phase(p);
                else { scan_phase(p, lds); grid.sync(); hgate_phase(p); }
                grid.sync();
                A2 = ob; K2 = 1024;
            }
            {
                pg8::Gemm g{A2, B2, M, 1024, K2}; pg8::StaticOrder S; S.init(M, 1024, G, (int)blockIdx.x);
                EpiF32 E{hb};
                pg8::gemm_phase<EpiF32, pg8::StaticOrder, true, true>(lds, g, S, E);
            }
            grid.sync();
        }
    }
    ew_phase(p, false, false, 0.5f, mod + (size_t)3 * 9 * 9216, 8, p.norm_g + (size_t)(3 * 6 + 5) * 1024, mod, 0, p.norm_g);
}

extern "C" void kernel_launch(void* const* d_in, const int* in_sizes, int n_in, void* d_out, int out_size, void* d_ws, size_t ws_size, hipStream_t stream) {
    static int grid = 0;
    if (grid == 0) {
        if (n_in != 23 || ws_size < WS_END) { fprintf(stderr, "kernel_launch: expected 23 inputs and >= %zu bytes of workspace; got %d, %zu\n", (size_t)WS_END, n_in, ws_size); grid = -1; return; }
        int dev = 0, cus = 0, per_cu = 0;
        hipGetDevice(&dev); hipDeviceGetAttribute(&cus, hipDeviceAttributeMultiprocessorCount, dev);
        if (hipFuncSetAttribute((const void*)fwd_megakernel, hipFuncAttributeMaxDynamicSharedMemorySize, LDS_BYTES) != hipSuccess) { fprintf(stderr, "kernel_launch: hipFuncSetAttribute failed\n"); grid = -1; return; }
        if (hipOccupancyMaxActiveBlocksPerMultiprocessor(&per_cu, (const void*)fwd_megakernel, NTHR, LDS_BYTES) != hipSuccess || per_cu < 1) { fprintf(stderr, "kernel_launch: occupancy query gave %d\n", per_cu); per_cu = 1; }
        (void)hipGetLastError();
        grid = cus * per_cu;
    }
    if (grid < 0) return;
    Params p{};
    const float** pp = (const float**)&p;
    for (int i = 0; i < 23; ++i) pp[i] = (const float*)d_in[i];
    p.out = (float*)d_out; p.ws = (unsigned char*)d_ws;
    void* args[] = {&p};
    hipError_t e = hipLaunchCooperativeKernel((const void*)fwd_megakernel, dim3(grid), dim3(NTHR), args, LDS_BYTES, stream);
    if (e != hipSuccess) fprintf(stderr, "cooperative launch failed: %s (grid %d)\n", hipGetErrorString(e), grid);
}
```

```cpp
#define PROBE 0
#include <hip/hip_runtime.h>
#include <hip/hip_cooperative_groups.h>
#include <cstdio>
#include <cstdint>
namespace cg = cooperative_groups;
__device__ __forceinline__ int opaque_tid() { int t = threadIdx.x; asm volatile("" : "+v"(t)); return t; }
namespace pg8 {
#define PG8_LAS __attribute__((address_space(3)))
typedef unsigned short bf16_t;
typedef short bf16x8 __attribute__((ext_vector_type(8)));
typedef float f32x4 __attribute__((ext_vector_type(4)));
typedef unsigned u32x4 __attribute__((ext_vector_type(4)));
constexpr int BM = 256, BK = 64, HALF = 128, HTB = HALF * BK * 2  , STAGE_BYTES = 8 * HTB, NXCD = 8, WGM = 8;

__host__ __device__ __forceinline__ int lds_byte(int r, int c) { const int st = (r >> 4) * 2 + (c >> 5), rr = r & 15, cc = c & 31, ob = rr * 64 + cc * 2; return st * 1024 + (ob ^ (((ob >> 9) & 1) << 5)); }
__host__ __device__ __forceinline__ void stage_rc(int b, int& R, int& C) { const int st = b / 1024, sb = b % 1024, swz = sb ^ (((sb >> 9) & 1) << 5); R = (st >> 1) * 16 + swz / 64; C = (st & 1) * 32 + (swz % 64) / 2; }
__host__ __device__ __forceinline__ int perm32(int rho) { const int n = rho >> 4, i = rho & 15; return 8 * (i >> 2) + 4 * n + (i & 3); }

struct Unit { int pm, pn; };
struct Gemm { const bf16_t* A; const bf16_t* Bt; int M, N, K; };

struct StaticOrder {
    int nM, nN, nwg, G, c;
    __host__ __device__ void init(int M, int N, int G_, int c_) { nM = M / BM; nN = N / BM; nwg = nM * nN; G = G_; c = c_; }
    __host__ __device__ bool next(int i, Unit& u) const {
        const long L = (long)i * G + c; if (L >= nwg) return false;
        int wgid = (int)L; { const int q = nwg / NXCD, r = nwg % NXCD, xcd = wgid % NXCD, off = wgid / NXCD; wgid = (xcd < r ? xcd * (q + 1) : r * (q + 1) + (xcd - r) * q) + off; }
        const int nig = WGM * nN, gid = wgid / nig, fm = gid * WGM, gsz = (nM - fm) < WGM ? (nM - fm) : WGM;
        u.pm = fm + ((wgid % nig) % gsz); u.pn = (wgid % nig) / gsz; return true;
    }
    __device__ __forceinline__ void a_ready(const Unit&) const {}
    __device__ __forceinline__ void done(const Unit&) const {}
};

__device__ __forceinline__ unsigned cvt_pk_bf16(float lo, float hi) { unsigned r; asm volatile("v_cvt_pk_bf16_f32 %0, %1, %2" : "=v"(r) : "v"(lo), "v"(hi)); return r; }
typedef float f32x2 __attribute__((ext_vector_type(2)));
template <class Epi, class Sched, bool ALIGN_EPI = false, bool SP2 = false>
__device__ __forceinline__ void gemm_phase(PG8_LAS unsigned char* lds, const Gemm g, const Sched& S, const Epi& E) {
    const int tid = opaque_tid(), wid = __builtin_amdgcn_readfirstlane(tid >> 6), lane = tid & 63, wr = wid >> 2, wc = wid & 3, fr = lane & 15, fq = lane >> 4;
    const int K = g.K, nt = K / BK;
    unsigned voffA[2], voffB[2];
#pragma unroll
    for (int i = 0; i < 2; ++i) { int R, C; stage_rc(tid * 16 + i * 8192, R, C); const int Rb = Epi::PERM ? ((R & ~31) + perm32(R & 31)) : R;
        voffA[i] = (unsigned)(R * K + C) * 2u; voffB[i] = (unsigned)(Rb * K + C) * 2u; }
    const size_t kstep = (size_t)(BK * 2);
    const size_t hstep = (size_t)HALF * K * 2;
    const size_t tstep = 2 * hstep;
    const unsigned ldsw = (unsigned)wid * 1024u;
    const int aoff = lds_byte(wr * 64 + fr, fq * 8), boff = lds_byte(wc * 32 + fr, fq * 8);
#define PG8_SA(b, h) (((b) * 2 + (h)) * HTB)
#define PG8_SB(b, h) ((4 + (b) * 2 + (h)) * HTB)
#define PG8_STAGE(bufoff, gbase, voff) do { _Pragma("unroll") for (int _i = 0; _i < 2; ++_i) \
        __builtin_amdgcn_global_load_lds((const unsigned*)((const char*)(gbase) + (voff)[_i]), (PG8_LAS unsigned*)(lds + (bufoff) + ldsw + _i * 8192), 16, 0, 0); } while (0)
#define PG8_LDA(dst, b, h) do { _Pragma("unroll") for (int m = 0; m < 4; ++m) _Pragma("unroll") for (int k = 0; k < 2; ++k) dst[m][k] = *(const PG8_LAS bf16x8*)(lds + PG8_SA(b, h) + aoff + m * 2048 + k * 1024); } while (0)
#define PG8_LDB(dst, b, h) do { _Pragma("unroll") for (int n = 0; n < 2; ++n) _Pragma("unroll") for (int k = 0; k < 2; ++k) dst[n][k] = *(const PG8_LAS bf16x8*)(lds + PG8_SB(b, h) + boff + n * 2048 + k * 1024); } while (0)
#define PG8_MMA(ai, bj, At, Bt) do { __builtin_amdgcn_s_setprio(1); _Pragma("unroll") for (int m = 0; m < 4; ++m) _Pragma("unroll") for (int n = 0; n < 2; ++n) _Pragma("unroll") for (int k = 0; k < 2; ++k) \
        acc[ai][bj][m][n] = __builtin_amdgcn_mfma_f32_16x16x32_bf16(Bt[n][k], At[m][k], acc[ai][bj][m][n], 0, 0, 0); __builtin_amdgcn_s_setprio(0); } while (0)
#define PG8_WAIT_V(n) asm volatile("s_waitcnt vmcnt(" #n ")" ::: "memory")
#define PG8_WAIT_L(n) asm volatile("s_waitcnt lgkmcnt(" #n ")" ::: "memory")
#define PG8_BAR __builtin_amdgcn_s_barrier()
#define PG8_SCHED __builtin_amdgcn_sched_barrier(0)
    Unit cur, nxt; int ui = 0;
    if (!S.next(0, cur)) return;
    f32x4 acc[2][2][4][2];
#pragma unroll
    for (int a = 0; a < 2; ++a)
#pragma unroll
        for (int b = 0; b < 2; ++b)
#pragma unroll
            for (int m = 0; m < 4; ++m)
#pragma unroll
                for (int n = 0; n < 2; ++n) acc[a][b][m][n] = (f32x4){0.f, 0.f, 0.f, 0.f};
    bf16x8 At[4][2], B0[2][2], B1[2][2];
    const char* cA = (const char*)g.A + (size_t)cur.pm * tstep; const char* cB = (const char*)g.Bt + (size_t)cur.pn * tstep;
    S.a_ready(cur);
    if constexpr (SP2) {
        PG8_STAGE(PG8_SB(0, 0), cB, voffB); PG8_STAGE(PG8_SB(0, 1), cB + hstep, voffB); PG8_STAGE(PG8_SA(0, 0), cA, voffA); PG8_STAGE(PG8_SA(0, 1), cA + hstep, voffA);
        if (wr == 1) PG8_BAR;
        PG8_WAIT_V(2); PG8_BAR;
        PG8_STAGE(PG8_SB(1, 0), cB + kstep, voffB); PG8_STAGE(PG8_SA(1, 0), cA + kstep, voffA); PG8_STAGE(PG8_SB(1, 1), cB + hstep + kstep, voffB);
        PG8_WAIT_V(6); PG8_BAR;
    } else {
        PG8_STAGE(PG8_SB(0, 0), cB, voffB); PG8_STAGE(PG8_SA(0, 0), cA, voffA); PG8_STAGE(PG8_SB(0, 1), cB + hstep, voffB); PG8_STAGE(PG8_SA(0, 1), cA + hstep, voffA);
        if (wr == 1) PG8_BAR;
        PG8_WAIT_V(4); PG8_BAR;
        PG8_STAGE(PG8_SB(1, 0), cB + kstep, voffB); PG8_STAGE(PG8_SA(1, 0), cA + kstep, voffA); PG8_STAGE(PG8_SB(1, 1), cB + hstep + kstep, voffB);
        PG8_WAIT_V(6); PG8_BAR;
    }
    for (;;) {
        const bool has_next = S.next(ui + 1, nxt);
        const char* nA = has_next ? (const char*)g.A + (size_t)nxt.pm * tstep : cA; const char* nB = has_next ? (const char*)g.Bt + (size_t)nxt.pn * tstep : cB;
        for (int t = 0; t < nt; t += 2) {
            const bool last = (t == nt - 2);
            const char* a1 = cA + (size_t)(t + 1) * kstep;
            const char* a2 = last ? nA : cA + (size_t)(t + 2) * kstep; const char* b2 = last ? nB : cB + (size_t)(t + 2) * kstep;
            const char* a3 = a2 + kstep; const char* b3 = b2 + kstep;
            if (last && has_next) S.a_ready(nxt);
            if constexpr (SP2) {
            PG8_LDB(B0, 0, 0); PG8_LDB(B1, 0, 1); PG8_SCHED; PG8_LDA(At, 0, 0); PG8_STAGE(PG8_SA(1, 1), a1 + hstep, voffA);
            PG8_WAIT_V(8); PG8_WAIT_L(0); PG8_BAR; PG8_MMA(0, 0, At, B0); PG8_MMA(0, 1, At, B1); PG8_BAR; PG8_SCHED;
            PG8_LDA(At, 0, 1); PG8_STAGE(PG8_SB(0, 0), b2, voffB); PG8_STAGE(PG8_SB(0, 1), b2 + hstep, voffB); PG8_STAGE(PG8_SA(0, 0), a2, voffA);
            PG8_WAIT_V(8); PG8_WAIT_L(0); PG8_BAR; PG8_MMA(1, 0, At, B0); PG8_MMA(1, 1, At, B1); PG8_BAR; PG8_SCHED;
            PG8_LDB(B0, 1, 0); PG8_LDB(B1, 1, 1); PG8_SCHED; PG8_LDA(At, 1, 0); PG8_STAGE(PG8_SA(0, 1), a2 + hstep, voffA);
            PG8_WAIT_V(8); PG8_WAIT_L(0); PG8_BAR; PG8_MMA(0, 0, At, B0); PG8_MMA(0, 1, At, B1); PG8_BAR; PG8_SCHED;
            PG8_LDA(At, 1, 1); PG8_STAGE(PG8_SB(1, 0), b3, voffB); PG8_STAGE(PG8_SB(1, 1), b3 + hstep, voffB); PG8_STAGE(PG8_SA(1, 0), a3, voffA);
            PG8_WAIT_V(8); PG8_WAIT_L(0); PG8_BAR; PG8_MMA(1, 0, At, B0); PG8_MMA(1, 1, At, B1); PG8_BAR; PG8_SCHED;
            } else {
            PG8_LDB(B0, 0, 0); PG8_SCHED; PG8_LDA(At, 0, 0); PG8_STAGE(PG8_SA(1, 1), a1 + hstep, voffA);
            PG8_WAIT_L(8); PG8_BAR; PG8_WAIT_L(0); PG8_MMA(0, 0, At, B0); PG8_BAR; PG8_SCHED;
            PG8_LDB(B1, 0, 1); PG8_STAGE(PG8_SB(0, 0), b2, voffB);
            PG8_BAR; PG8_WAIT_L(0); PG8_MMA(0, 1, At, B1); PG8_BAR;
            PG8_LDA(At, 0, 1); PG8_STAGE(PG8_SA(0, 0), a2, voffA);
            PG8_BAR; PG8_WAIT_L(0); PG8_MMA(1, 0, At, B0); PG8_BAR; PG8_SCHED;
            PG8_STAGE(PG8_SB(0, 1), b2 + hstep, voffB);
            PG8_WAIT_V(6); PG8_BAR; PG8_MMA(1, 1, At, B1); PG8_BAR;
            PG8_LDB(B0, 1, 0); PG8_SCHED; PG8_LDA(At, 1, 0); PG8_STAGE(PG8_SA(0, 1), a2 + hstep, voffA);
            PG8_WAIT_L(8); PG8_BAR; PG8_WAIT_L(0); PG8_MMA(0, 0, At, B0); PG8_BAR; PG8_SCHED;
            PG8_LDB(B1, 1, 1); PG8_STAGE(PG8_SB(1, 0), b3, voffB);
            PG8_BAR; PG8_WAIT_L(0); PG8_MMA(0, 1, At, B1); PG8_BAR;
            PG8_LDA(At, 1, 1); PG8_STAGE(PG8_SA(1, 0), a3, voffA);
            PG8_BAR; PG8_WAIT_L(0); PG8_MMA(1, 0, At, B0); PG8_BAR; PG8_SCHED;
            PG8_STAGE(PG8_SB(1, 1), b3 + hstep, voffB);
            PG8_WAIT_V(6); PG8_BAR; PG8_MMA(1, 1, At, B1); PG8_BAR;
            }
        }
        if constexpr (ALIGN_EPI) { if (wr == 0) PG8_BAR; }
        if constexpr (!Epi::AFTER_DRAIN) { E(acc, cur, wr, wc, fr, fq); S.done(cur); }
        if (!has_next) break;
#pragma unroll
        for (int a = 0; a < 2; ++a)
#pragma unroll
            for (int b = 0; b < 2; ++b)
#pragma unroll
                for (int m = 0; m < 4; ++m)
#pragma unroll
                    for (int n = 0; n < 2; ++n) acc[a][b][m][n] = (f32x4){0.f, 0.f, 0.f, 0.f};
        cur = nxt; cA = nA; cB = nB; ++ui;
        if constexpr (ALIGN_EPI) { if (wr == 1) PG8_BAR; }
    }
    PG8_WAIT_V(0);
    if constexpr (!ALIGN_EPI) { if (wr == 0) PG8_BAR; }
    PG8_BAR;
    if constexpr (Epi::AFTER_DRAIN) { E.fused(acc, cur, wr, wc, fr, fq, lds, wid, lane); S.done(cur); }
#undef PG8_SA
#undef PG8_SB
#undef PG8_STAGE
#undef PG8_LDA
#undef PG8_LDB
#undef PG8_MMA
#undef PG8_WAIT_V
#undef PG8_WAIT_L
#undef PG8_BAR
#undef PG8_SCHED
}
}
#define LAS __attribute__((address_space(3)))
typedef unsigned short bf16;
typedef unsigned v4u __attribute__((ext_vector_type(4)));
typedef unsigned v2u __attribute__((ext_vector_type(2)));
typedef float f32x4 __attribute__((ext_vector_type(4)));
typedef float f32x2 __attribute__((ext_vector_type(2)));
typedef float f32x16 __attribute__((ext_vector_type(16)));
typedef short bf16x8 __attribute__((ext_vector_type(8)));

constexpr int NTHR = 512;
constexpr int D = 1024, MP = 4096, MS = 8192, M = MP + MS, DFF = 2816, DEPTH = 4;
constexpr int LDS_BYTES = 147456;
constexpr float EPS = 1e-6f;
constexpr float LOG2E = 1.4426950408889634f;

constexpr size_t MiB = 1u << 20;
constexpr size_t WS_FFNIN = 0;
constexpr size_t WS_FFNOUT = WS_FFNIN + 8ull * 5632 * 1024 * 2;
constexpr size_t WS_QKV = WS_FFNOUT + 8ull * 1024 * 2816 * 2;
constexpr size_t WS_AO = WS_QKV + 2ull * 1536 * 1024 * 2;
constexpr size_t WS_CIN = WS_AO + 2ull * 1024 * 1024 * 2;
constexpr size_t WS_COUT = WS_CIN + 3072ull * 1024 * 2;
constexpr size_t WS_HIN = WS_COUT + 1024ull * 1024 * 2;
constexpr size_t WS_HOUT = WS_HIN + 5120ull * 1024 * 2;
constexpr size_t WS_MOD = WS_HOUT + 1024ull * 1024 * 2;
constexpr size_t WS_ROPE = WS_MOD + 2 * MiB;
constexpr size_t WS_LB = WS_ROPE + MiB;
constexpr size_t WS_CK = WS_LB + MiB;
constexpr size_t WS_CV = WS_CK + 2 * MiB;
constexpr size_t WS_HN = WS_CV + 2 * MiB;
constexpr size_t WS_Z = WS_HN + 24 * MiB;
constexpr size_t WS_H = WS_Z + 120 * MiB;
constexpr size_t WS_O = WS_H + 48 * MiB;
constexpr size_t WS_OF = WS_O + 24 * MiB;
constexpr size_t WS_OB = WS_OF + 48 * MiB;
constexpr size_t WS_CTL = WS_OB + 48 * MiB, CTL_BYTES = 16384;
constexpr size_t WS_END = WS_CTL + MiB;
constexpr int MISC_OFF = 131072 + 320;

constexpr size_t OUT_YS = (size_t)MP * D, OUT_K = (size_t)M * D, OUT_V = OUT_K + 16ull * 2 * 256 * 256, OUT_ST = OUT_V + 16ull * 2 * 256 * 256;

struct Params {
    const float *x_prompt, *x_sample, *cache_k, *cache_v, *state_hgrn, *c, *c_ctx, *w_ada, *b_ada, *norm_g, *w_ffn_in, *w_ffn_out,
        *w_attn_qkv, *w_attn_o, *attn_sink, *w_conv_in, *conv_w, *conv_b, *w_conv_out, *w_hgrn_in, *hgrn_lb, *hgrn_norm_g, *w_hgrn_out;
    float* out; unsigned char* ws;
};

__device__ __forceinline__ unsigned f2bf(float f) { unsigned u = __builtin_bit_cast(unsigned, f); return (u + 0x7fffu + ((u >> 16) & 1u)) >> 16; }
__device__ __forceinline__ unsigned pk2(float lo, float hi) { return f2bf(lo) | (f2bf(hi) << 16); }
__device__ __forceinline__ float bflo(unsigned u) { return __uint_as_float(u << 16); }
__device__ __forceinline__ float bfhi(unsigned u) { return __uint_as_float(u & 0xffff0000u); }
__device__ __forceinline__ float sigmoid_f(float a) { return __builtin_amdgcn_rcpf(1.f + __expf(-a)); }
__device__ __forceinline__ float silu_f(float a) { return a * sigmoid_f(a); }
__device__ __forceinline__ float wave_sum(float v) {
#pragma unroll
    for (int o = 1; o < 64; o <<= 1) v += __shfl_xor(v, o);
    return v;
}
#define LDS_WAIT() asm volatile("s_waitcnt lgkmcnt(0)" ::: "memory")

struct EpiSwiGLU {
    static constexpr bool PERM = true, AFTER_DRAIN = false;
    bf16* O;
    __device__ __forceinline__ void operator()(const pg8::f32x4 (&acc)[2][2][4][2], const pg8::Unit& u, int wr, int wc, int fr, int fq) const {
        const int row0 = u.pm * 256 + wr * 64 + fr, col0 = u.pn * 128 + wc * 32 + 8 * fq;
#pragma unroll
        for (int ai = 0; ai < 2; ++ai)
#pragma unroll
            for (int m = 0; m < 4; ++m) {
                bf16* rowp = O + (size_t)(row0 + ai * 128 + m * 16) * DFF + col0;
                const pg8::f32x4 a0 = acc[ai][0][m][0], a1 = acc[ai][0][m][1], b0 = acc[ai][1][m][0], b1 = acc[ai][1][m][1];
                v4u w;
                w.x = pg8::cvt_pk_bf16(silu_f(a0[0]) * b0[0], silu_f(a0[1]) * b0[1]); w.y = pg8::cvt_pk_bf16(silu_f(a0[2]) * b0[2], silu_f(a0[3]) * b0[3]);
                w.z = pg8::cvt_pk_bf16(silu_f(a1[0]) * b1[0], silu_f(a1[1]) * b1[1]); w.w = pg8::cvt_pk_bf16(silu_f(a1[2]) * b1[2], silu_f(a1[3]) * b1[3]);
                *(v4u*)rowp = w;
            }
    }
};
struct EpiF32 {
    static constexpr bool PERM = false, AFTER_DRAIN = false;
    float* O;
    __device__ __forceinline__ void operator()(const pg8::f32x4 (&acc)[2][2][4][2], const pg8::Unit& u, int wr, int wc, int fr, int fq) const {
        const int row0 = u.pm * 256 + wr * 64 + fr, col0 = u.pn * 256 + wc * 32 + 4 * fq;
#pragma unroll
        for (int ai = 0; ai < 2; ++ai)
#pragma unroll
            for (int m = 0; m < 4; ++m) {
                float* rowp = O + (size_t)(row0 + ai * 128 + m * 16) * D + col0;
#pragma unroll
                for (int bj = 0; bj < 2; ++bj)
#pragma unroll
                    for (int n = 0; n < 2; ++n) *(pg8::f32x4*)(rowp + bj * 128 + n * 16) = acc[ai][bj][m][n];
            }
    }
};
struct EpiZ {
    static constexpr bool PERM = true, AFTER_DRAIN = false;
    bf16* O; int ldc; float* kout; float* vout;
    __device__ __forceinline__ void operator()(const pg8::f32x4 (&acc)[2][2][4][2], const pg8::Unit& u, int wr, int wc, int fr, int fq) const {
        const int row0 = u.pm * 256 + wr * 64 + fr, col0 = u.pn * 256 + wc * 32 + 8 * fq;
        const bool kv = (kout != nullptr) && u.pn >= 4 && u.pm < 16;
        float* kvb = (u.pn == 4) ? kout : vout;
#pragma unroll
        for (int ai = 0; ai < 2; ++ai)
#pragma unroll
            for (int m = 0; m < 4; ++m) {
                const int row = row0 + ai * 128 + m * 16;
                bf16* rowp = O + (size_t)row * ldc + col0;
#pragma unroll
                for (int bj = 0; bj < 2; ++bj) {
                    const pg8::f32x4 v0 = acc[ai][bj][m][0], v1 = acc[ai][bj][m][1];
                    v4u w; w.x = pg8::cvt_pk_bf16(v0[0], v0[1]); w.y = pg8::cvt_pk_bf16(v0[2], v0[3]); w.z = pg8::cvt_pk_bf16(v1[0], v1[1]); w.w = pg8::cvt_pk_bf16(v1[2], v1[3]);
                    *(v4u*)(rowp + bj * 128) = w;
                    if (kv) { float* dst = kvb + (size_t)(row >> 8) * (2 * 65536) + (size_t)(row & 255) * 256 + wc * 32 + 8 * fq + bj * 128;
                        *(pg8::f32x4*)dst = v0; *(pg8::f32x4*)(dst + 4) = v1; }
                }
            }
    }
};
#define XB_TMO      128
#define XB_XCNT(j)  (256  + 64 * (j))
#define XB_XSUB(j)  (1280 + 64 * (j))
#define XB_XGEN(j)  (2304 + 64 * (j))
#define XB_TOP      3328
#define XB_TOPGEN   3392
#define XCD_BAR_WORDS 3456
#define XB_SPIN_CAP (1u << 18)

__device__ __forceinline__ unsigned xb_ld(unsigned* p)              { return __hip_atomic_load(p, __ATOMIC_RELAXED, __HIP_MEMORY_SCOPE_AGENT); }
__device__ __forceinline__ unsigned xb_add(unsigned* p, unsigned v) { return __hip_atomic_fetch_add(p, v, __ATOMIC_RELAXED, __HIP_MEMORY_SCOPE_AGENT); }
__device__ __forceinline__ unsigned xb_xcc_id() { return (unsigned)__builtin_amdgcn_s_getreg((3 << 11) | 20) & 0xFu; }
#define XB_SPIN(cond, bar) do { unsigned _sp = 0; while (cond) { __builtin_amdgcn_s_sleep(1); \
    if ((++_sp & 255u) == 0u) { if (xb_ld(&(bar)[XB_TMO])) break; if (_sp > XB_SPIN_CAP) { atomicAdd(&(bar)[XB_TMO], 1u); break; } } } } while (0)

struct XcdBarrier {
    unsigned* bar; unsigned x;
    volatile LAS unsigned* st;
};

__device__ __forceinline__ XcdBarrier xcd_barrier_post(unsigned* bar, volatile LAS unsigned* st) {
    XcdBarrier b; b.bar = bar; b.x = xb_xcc_id(); b.st = st;
    if (threadIdx.x == 0) (void)xb_add(&bar[XB_XCNT(b.x)], 1u);
    return b;
}
__device__ __forceinline__ void xcd_barrier_complete(unsigned* bar, unsigned x, unsigned& nloc, unsigned& nx) {
    const unsigned G = gridDim.x * gridDim.y * gridDim.z;
    unsigned sum, cnt, mine, sp = 0u;
    for (;;) {
        sum = 0u; cnt = 0u; mine = 0u;
#pragma unroll
        for (unsigned j = 0; j < 16; ++j) { const unsigned c = xb_ld(&bar[XB_XCNT(j)]); sum += c; cnt += (c > 0u) ? 1u : 0u; mine = (j == x) ? c : mine; }
        if (sum == G) break;
        __builtin_amdgcn_s_sleep(1);
        if ((++sp & 255u) == 0u) { if (xb_ld(&bar[XB_TMO])) break; if (sp > XB_SPIN_CAP) { atomicAdd(&bar[XB_TMO], 1u); break; } }
    }
    nloc = mine > 0u ? mine : 1u; nx = cnt > 0u ? cnt : 1u;
}

__device__ __forceinline__ void xcd_barrier(const XcdBarrier& b) {
    asm volatile("s_waitcnt vmcnt(0)" ::: "memory");
    __syncthreads();
    if (threadIdx.x == 0) {
        unsigned* bar = b.bar;
        __builtin_amdgcn_s_waitcnt(0);
        unsigned nloc = b.st[0], nx = b.st[1];
        if (nloc == 0u) { xcd_barrier_complete(bar, b.x, nloc, nx); b.st[0] = nloc; b.st[1] = nx; }
        const unsigned old = xb_add(&bar[XB_XSUB(b.x)], 1u);
        const unsigned gen = old / nloc;
        if (old + 1u == (gen + 1u) * nloc) {
            __builtin_amdgcn_fence(__ATOMIC_RELEASE, "agent");
            asm volatile("s_waitcnt vmcnt(0)" ::: "memory");
            const unsigned og = xb_add(&bar[XB_TOP], 1u);
            const unsigned tg = og / nx;
            if (og + 1u == (tg + 1u) * nx) xb_add(&bar[XB_TOPGEN], 1u);
            else XB_SPIN(xb_ld(&bar[XB_TOPGEN]) == tg, bar);
            __builtin_amdgcn_fence(__ATOMIC_ACQUIRE, "agent");
            xb_add(&bar[XB_XGEN(b.x)], 1u);
            asm volatile("s_waitcnt vmcnt(0)" ::: "memory");
        } else {
            XB_SPIN(xb_ld(&bar[XB_XGEN(b.x)]) == gen, bar);
            __builtin_amdgcn_fence(__ATOMIC_ACQUIRE, "agent");
            asm volatile("s_waitcnt vmcnt(0)" ::: "memory");
        }
    }
    __syncthreads();
}
__device__ __forceinline__ void p0_transpose_item(const float* W, int K, int N, bf16* WT, int k0, int n0, int drow0, LAS float* scr, int lane) {
#pragma unroll 8
    for (int i = 0; i < 32; ++i) { const int kk = 2 * i + (lane >> 5); scr[kk * 33 + (lane & 31)] = W[(size_t)(k0 + kk) * N + n0 + (lane & 31)]; }
    LDS_WAIT(); asm volatile("" ::: "memory");
    const int c = lane & 7;
#pragma unroll
    for (int j = 0; j < 4; ++j) { const int n = (lane >> 3) + 8 * j; const LAS float* s = scr + (8 * c) * 33 + n;
        v4u o; o.x = pk2(s[0 * 33], s[1 * 33]); o.y = pk2(s[2 * 33], s[3 * 33]); o.z = pk2(s[4 * 33], s[5 * 33]); o.w = pk2(s[6 * 33], s[7 * 33]);
        *(v4u*)(WT + (size_t)(drow0 + n) * K + k0 + 8 * c) = o; }
    LDS_WAIT(); asm volatile("" ::: "memory");
}

constexpr int IT_FI = 16 * 176, IT_FO = 44 * 32, IT_QKV = 16 * 48, IT_SQ = 16 * 32, IT_CI = 16 * 96, IT_HI = 16 * 160;
constexpr int C0 = 8 * IT_FI, C1 = C0 + 8 * IT_FO, C2 = C1 + 2 * IT_QKV, C3 = C2 + 2 * IT_SQ, C4 = C3 + IT_CI, C5 = C4 + IT_SQ, C6 = C5 + IT_HI, C7 = C6 + IT_SQ;

__device__ __forceinline__ void p0_prologue(const Params& p, LAS unsigned char* lds) {
    const int tid = opaque_tid(), lane = tid & 63, wave = __builtin_amdgcn_readfirstlane(tid >> 6);
    const int gt = blockIdx.x * NTHR + tid, NGT = gridDim.x * NTHR;
    const int gw = blockIdx.x * 8 + wave, NGW = gridDim.x * 8;
    { float* cs = (float*)(p.ws + WS_ROPE); float* sn = cs + 1024 * 32;
      for (int i = gt; i < 1024 * 32; i += NGT) { const int t = i >> 5, k = i & 31; const float pos = (float)(k < 16 ? (t >> 6) : (t & 63));
          const float inv = exp2f(-(float)(k & 15) * (13.287712379549449f / 16.0f));
          const float ang = pos * inv; cs[i] = __cosf(ang); sn[i] = __sinf(ang); } }
    { float* lbt = (float*)(p.ws + WS_LB);
      for (int i = gt; i < 2048; i += NGT) { const int dir = i >> 10, d = i & 1023; const float* q = p.hgrn_lb + (size_t)dir * DEPTH * 1024 + d;
          const float a0 = q[0], a1 = q[1024], a2 = q[2048], a3 = q[3072]; const float mx = fmaxf(fmaxf(a0, a1), fmaxf(a2, a3));
          const float e0 = expf(a0 - mx), e1 = expf(a1 - mx), e2 = expf(a2 - mx), e3 = expf(a3 - mx);
          lbt[i] = (e1 + e2) / (e0 + e1 + e2 + e3); } }
    { bf16* ck = (bf16*)(p.ws + WS_CK); bf16* cv = (bf16*)(p.ws + WS_CV);
      for (int i = gt; i < 8 * 2 * 256 * 256 / 4; i += NGT) { const f32x4 a = ((const f32x4*)p.cache_k)[i], b = ((const f32x4*)p.cache_v)[i];
          v2u wa, wb; wa.x = pk2(a.x, a.y); wa.y = pk2(a.z, a.w); wb.x = pk2(b.x, b.y); wb.y = pk2(b.z, b.w);
          ((v2u*)ck)[i] = wa; ((v2u*)cv)[i] = wb; } }
    { LAS float* sc = (LAS float*)lds;
      LAS float* red = (LAS float*)(lds + 49152);
      for (int i = tid; i < 9 * 1024; i += NTHR) { const int cnd = i >> 10, k = i & 1023; const float v = cnd == 0 ? p.c_ctx[k] : p.c[(cnd - 1) * 1024 + k]; sc[k * 12 + cnd] = v / (1.f + expf(-v)); }
      __syncthreads();
      float* mod = (float*)(p.ws + WS_MOD);
      for (int task = blockIdx.x; task < 288; task += gridDim.x) {
          const int li = task / 72, cgp = task % 72;
          const float* W = p.w_ada + (size_t)li * 1024 * 9216 + cgp * 128 + 2 * lane;
          float a0[9], a1[9];
#pragma unroll
          for (int q = 0; q < 9; ++q) { a0[q] = 0.f; a1[q] = 0.f; }
          const int k0 = wave * 128;
#pragma unroll 8
          for (int k = k0; k < k0 + 128; ++k) {
              const f32x2 w = *(const f32x2*)(W + (size_t)k * 9216);
              const f32x4 s0 = *(const LAS f32x4*)(sc + k * 12), s1 = *(const LAS f32x4*)(sc + k * 12 + 4), s2 = *(const LAS f32x4*)(sc + k * 12 + 8);
              a0[0] += s0.x * w.x; a1[0] += s0.x * w.y; a0[1] += s0.y * w.x; a1[1] += s0.y * w.y; a0[2] += s0.z * w.x; a1[2] += s0.z * w.y; a0[3] += s0.w * w.x; a1[3] += s0.w * w.y;
              a0[4] += s1.x * w.x; a1[4] += s1.x * w.y; a0[5] += s1.y * w.x; a1[5] += s1.y * w.y; a0[6] += s1.z * w.x; a1[6] += s1.z * w.y; a0[7] += s1.w * w.x; a1[7] += s1.w * w.y;
              a0[8] += s2.x * w.x; a1[8] += s2.x * w.y;
          }
#pragma unroll
          for (int q = 0; q < 9; ++q) *(LAS f32x2*)(red + (wave * 9 + q) * 128 + 2 * lane) = (f32x2){a0[q], a1[q]};
          __syncthreads();
          for (int i = tid; i < 9 * 128; i += NTHR) { const int q = i >> 7, cc = i & 127; float s = 0.f;
#pragma unroll
              for (int w8 = 0; w8 < 8; ++w8) s += red[(w8 * 9 + q) * 128 + cc];
              const int col = cgp * 128 + cc; mod[((size_t)li * 9 + q) * 9216 + col] = s + p.b_ada[li * 9216 + col]; }
          __syncthreads();
      }
    }
    { LAS float* scr = (LAS float*)(lds + wave * 16384);
      for (int it = gw; it < C7; it += NGW) {
          const float* W; bf16* WT; int K, N, r; bool swi = false;
          if (it < C0) { const int mi = it / IT_FI; r = it % IT_FI; W = p.w_ffn_in + (size_t)mi * 1024 * 5632; WT = (bf16*)(p.ws + WS_FFNIN) + (size_t)mi * 5632 * 1024; K = 1024; N = 5632; swi = true; }
          else if (it < C1) { const int q = it - C0, mi = q / IT_FO; r = q % IT_FO; W = p.w_ffn_out + (size_t)mi * 2816 * 1024; WT = (bf16*)(p.ws + WS_FFNOUT) + (size_t)mi * 1024 * 2816; K = 2816; N = 1024; }
          else if (it < C2) { const int q = it - C1, mi = q / IT_QKV; r = q % IT_QKV; W = p.w_attn_qkv + (size_t)mi * 1024 * 1536; WT = (bf16*)(p.ws + WS_QKV) + (size_t)mi * 1536 * 1024; K = 1024; N = 1536; }
          else if (it < C3) { const int q = it - C2, mi = q / IT_SQ; r = q % IT_SQ; W = p.w_attn_o + (size_t)mi * 1024 * 1024; WT = (bf16*)(p.ws + WS_AO) + (size_t)mi * 1024 * 1024; K = 1024; N = 1024; }
          else if (it < C4) { r = it - C3; W = p.w_conv_in; WT = (bf16*)(p.ws + WS_CIN); K = 1024; N = 3072; }
          else if (it < C5) { r = it - C4; W = p.w_conv_out; WT = (bf16*)(p.ws + WS_COUT); K = 1024; N = 1024; }
          else if (it < C6) { r = it - C5; W = p.w_hgrn_in; WT = (bf16*)(p.ws + WS_HIN); K = 1024; N = 5120; }
          else { r = it - C6; W = p.w_hgrn_out; WT = (bf16*)(p.ws + WS_HOUT); K = 1024; N = 1024; }
          const int nblk = N / 32, kb = r / nblk, nb = r % nblk, n0 = 32 * nb;
          int drow0 = n0;
          if (swi) { drow0 = n0 < DFF ? (n0 / 128) * 256 + (n0 % 128) : ((n0 - DFF) / 128) * 256 + 128 + ((n0 - DFF) % 128); }
          p0_transpose_item(W, K, N, WT, 64 * kb, n0, drow0, scr, lane);
      }
    }
}

__device__ __forceinline__ void ew_phase(const Params& p, bool first, bool has_next, float res_scale,
                                         const float* modh, int gate_idx, const float* g_post, const float* modn, int sub_next, const float* g_pre) {
    const int tid = opaque_tid(), lane = tid & 63, wave = __builtin_amdgcn_readfirstlane(tid >> 6);
    const float* hbuf = (const float*)(p.ws + WS_H); bf16* hn = (bf16*)(p.ws + WS_HN);
    for (int m = blockIdx.x * 8 + wave; m < M; m += gridDim.x * 8) {
        const int cond = m < MP ? 0 : 1 + ((m - MP) >> 10);
        float* xo = p.out + (size_t)m * D;
        f32x4 x[4];
        if (first) { const f32x4* xi = (const f32x4*)(m < MP ? p.x_prompt + (size_t)m * D : p.x_sample + (size_t)(m - MP) * D) + lane;
#pragma unroll
            for (int j = 0; j < 4; ++j) x[j] = xi[64 * j];
        } else {
            const f32x4* xi = (const f32x4*)xo + lane; const f32x4* hi = (const f32x4*)(hbuf + (size_t)m * D) + lane;
            const f32x4* gt = (const f32x4*)(modh + (size_t)cond * 9216 + gate_idx * 1024) + lane; const f32x4* gp = (const f32x4*)g_post + lane;
            f32x4 h[4]; float ss = 0.f;
#pragma unroll
            for (int j = 0; j < 4; ++j) { h[j] = hi[64 * j]; x[j] = xi[64 * j]; ss += (h[j].x * h[j].x + h[j].y * h[j].y) + (h[j].z * h[j].z + h[j].w * h[j].w); }
            const float rs = res_scale * rsqrtf(wave_sum(ss) * (1.f / D) + EPS);
#pragma unroll
            for (int j = 0; j < 4; ++j) { const f32x4 g = gt[64 * j], q = gp[64 * j]; x[j] = x[j] + (h[j] * rs) * (g * q); }
        }
        { f32x4* xw = (f32x4*)xo + lane;
#pragma unroll
          for (int j = 0; j < 4; ++j) xw[64 * j] = x[j]; }
        if (has_next) {
            float ss = 0.f;
#pragma unroll
            for (int j = 0; j < 4; ++j) ss += (x[j].x * x[j].x + x[j].y * x[j].y) + (x[j].z * x[j].z + x[j].w * x[j].w);
            const float rs = rsqrtf(wave_sum(ss) * (1.f / D) + EPS);
            const f32x4* sh = (const f32x4*)(modn + (size_t)cond * 9216 + (3 * sub_next) * 1024) + lane; const f32x4* sc = (const f32x4*)(modn + (size_t)cond * 9216 + (3 * sub_next + 1) * 1024) + lane;
            const f32x4* gp = (const f32x4*)g_pre + lane;
            v2u* o8 = (v2u*)(hn + (size_t)m * D) + lane;
#pragma unroll
            for (int j = 0; j < 4; ++j) { const f32x4 g = gp[64 * j], s = sc[64 * j], t = sh[64 * j]; const f32x4 y = (x[j] * rs) * g * (s + 1.f) + t;
                v2u w; w.x = pk2(y.x, y.y); w.y = pk2(y.z, y.w); o8[64 * j] = w; }
        }
    }
}

__device__ __forceinline__ void conv_phase(const Params& p) {
    const int tid = opaque_tid(), lane = tid & 63, wave = __builtin_amdgcn_readfirstlane(tid >> 6);
    const bf16* z = (const bf16*)(p.ws + WS_Z); bf16* o = (bf16*)(p.ws + WS_O);
    for (int m = blockIdx.x * 8 + wave; m < M; m += gridDim.x * 8) {
        const int tpos = m < MP ? (m & 255) : ((m - MP) & 1023), L = m < MP ? 256 : 1024;
        const bool hp = tpos > 0, hx = tpos < L - 1;
        const bf16* zr = z + (size_t)m * 3072;
#pragma unroll
        for (int jj = 0; jj < 2; ++jj) {
            const int c0 = 8 * lane + 512 * jj;
            const v4u bg = *(const v4u*)(zr + c0), cg1 = *(const v4u*)(zr + 1024 + c0), u1 = *(const v4u*)(zr + 2048 + c0);
            v4u cg0 = (v4u){0u, 0u, 0u, 0u}, u0 = cg0, cg2 = cg0, u2 = cg0;
            if (hp) { cg0 = *(const v4u*)(zr - 3072 + 1024 + c0); u0 = *(const v4u*)(zr - 3072 + 2048 + c0); }
            if (hx) { cg2 = *(const v4u*)(zr + 3072 + 1024 + c0); u2 = *(const v4u*)(zr + 3072 + 2048 + c0); }
            const f32x4 w0a = *(const f32x4*)(p.conv_w + c0), w0b = *(const f32x4*)(p.conv_w + c0 + 4), w1a = *(const f32x4*)(p.conv_w + 1024 + c0), w1b = *(const f32x4*)(p.conv_w + 1024 + c0 + 4),
                        w2a = *(const f32x4*)(p.conv_w + 2048 + c0), w2b = *(const f32x4*)(p.conv_w + 2048 + c0 + 4), cba = *(const f32x4*)(p.conv_b + c0), cbb = *(const f32x4*)(p.conv_b + c0 + 4);
            float w0[8] = {w0a.x, w0a.y, w0a.z, w0a.w, w0b.x, w0b.y, w0b.z, w0b.w}, w1[8] = {w1a.x, w1a.y, w1a.z, w1a.w, w1b.x, w1b.y, w1b.z, w1b.w},
                  w2[8] = {w2a.x, w2a.y, w2a.z, w2a.w, w2b.x, w2b.y, w2b.z, w2b.w}, cb[8] = {cba.x, cba.y, cba.z, cba.w, cbb.x, cbb.y, cbb.z, cbb.w};
            float r[8];
#pragma unroll
            for (int e = 0; e < 4; ++e) {
                const float z0l = bflo(cg0[e]) * bflo(u0[e]), z0h = bfhi(cg0[e]) * bfhi(u0[e]), z1l = bflo(cg1[e]) * bflo(u1[e]), z1h = bfhi(cg1[e]) * bfhi(u1[e]),
                            z2l = bflo(cg2[e]) * bflo(u2[e]), z2h = bfhi(cg2[e]) * bfhi(u2[e]);
                r[2 * e] = bflo(bg[e]) * (cb[2 * e] + w0[2 * e] * z0l + w1[2 * e] * z1l + w2[2 * e] * z2l);
                r[2 * e + 1] = bfhi(bg[e]) * (cb[2 * e + 1] + w0[2 * e + 1] * z0h + w1[2 * e + 1] * z1h + w2[2 * e + 1] * z2h);
            }
            v4u w; w.x = pk2(r[0], r[1]); w.y = pk2(r[2], r[3]); w.z = pk2(r[4], r[5]); w.w = pk2(r[6], r[7]);
            *(v4u*)(o + (size_t)m * D + c0) = w;
        }
    }
}
__device__ __forceinline__ int crow(int r, int h) { return (r & 3) + 8 * (r >> 2) + 4 * h; }
__device__ __forceinline__ void attn_phase(const Params& p, LAS unsigned char* lds, int j) {
    const int tid = opaque_tid(), lane = tid & 63, wave = __builtin_amdgcn_readfirstlane(tid >> 6);
    const bf16* z = (const bf16*)(p.ws + WS_Z); bf16* o = (bf16*)(p.ws + WS_O);
    const bf16* ck = (const bf16*)(p.ws + WS_CK); const bf16* cv = (const bf16*)(p.ws + WS_CV);
    const float* cs = (const float*)(p.ws + WS_ROPE); const float* sn = cs + 1024 * 32;
    LAS bf16* Ks = (LAS bf16*)lds;
    LAS bf16* Vt = (LAS bf16*)(lds + 32 * 72 * 2);
    const int half = lane >> 5, n = lane & 31, g = wave >> 1, qs = wave & 1;
    for (int u = blockIdx.x; u < 768; u += gridDim.x) {
        const bool smp = u < 512;
        int b, kvh, qb, row0;
        if (smp) { b = u >> 6; kvh = (u >> 4) & 3; qb = u & 15; row0 = MP + b * 1024; }
        else { const int r = u - 512; b = r >> 4; kvh = (r >> 2) & 3; qb = r & 3; row0 = b * 256; }
        const int head = kvh * 4 + g, qpos = qb * 64 + qs * 32 + n;
        bf16x8 qf[4];
        { const bf16* qrow = z + (size_t)(row0 + qpos) * 1536 + head * 64 + 8 * half;
          float q[4][8];
#pragma unroll
          for (int ks = 0; ks < 4; ++ks) { const v4u r = *(const v4u*)(qrow + 16 * ks);
#pragma unroll
              for (int e = 0; e < 4; ++e) { q[ks][2 * e] = bflo(r[e]); q[ks][2 * e + 1] = bfhi(r[e]); } }
          if (smp) {
#pragma unroll
              for (int ks = 0; ks < 2; ++ks) { const float* cp = cs + qpos * 32 + 16 * ks + 8 * half; const float* sp = sn + qpos * 32 + 16 * ks + 8 * half;
                  const f32x4 c0 = *(const f32x4*)cp, c1 = *(const f32x4*)(cp + 4), s0 = *(const f32x4*)sp, s1 = *(const f32x4*)(sp + 4);
                  const float cc[8] = {c0.x, c0.y, c0.z, c0.w, c1.x, c1.y, c1.z, c1.w}, ss[8] = {s0.x, s0.y, s0.z, s0.w, s1.x, s1.y, s1.z, s1.w};
#pragma unroll
                  for (int e = 0; e < 8; ++e) { const float x1 = q[ks][e], x2 = q[ks + 2][e]; q[ks][e] = x1 * cc[e] - x2 * ss[e]; q[ks + 2][e] = x1 * ss[e] + x2 * cc[e]; } }
          }
          const float qsc = 0.125f * LOG2E;
#pragma unroll
          for (int ks = 0; ks < 4; ++ks) { v4u w;
#pragma unroll
              for (int e = 0; e < 4; ++e) w[e] = pk2(q[ks][2 * e] * qsc, q[ks][2 * e + 1] * qsc);
              qf[ks] = __builtin_bit_cast(bf16x8, w); }
        }
        float m_run = p.attn_sink[j * 16 + head] * LOG2E, l_run = 1.f;
        f32x16 O0, O1;
#pragma unroll
        for (int i = 0; i < 16; ++i) { O0[i] = 0.f; O1[i] = 0.f; }
        int lat_lo = 0, lat_n = 8;
        if (smp) { const int lo = max(0, qb * 64 - 128), hi = min(1024, qb * 64 + 192); lat_lo = lo; lat_n = (hi - lo) >> 5; }
        const int ntile = lat_n + (smp ? 8 : 0);
        for (int t = 0; t < ntile; ++t) {
            const bool is_lat = t < lat_n;
            const bf16 *kbase, *vbase; int pitch, kstart;
            if (is_lat) { kstart = lat_lo + 32 * t; kbase = z + (size_t)(row0 + kstart) * 1536 + 1024 + kvh * 64; vbase = kbase + 256; pitch = 1536; }
            else { kstart = 32 * (t - lat_n); kbase = ck + (size_t)((b * 2 + j) * 256 + kstart) * 256 + kvh * 64; vbase = cv + (size_t)((b * 2 + j) * 256 + kstart) * 256 + kvh * 64; pitch = 256; }
            __syncthreads();
            { const int key = tid >> 4, c = tid & 15;
              const bf16* kr = kbase + (size_t)key * pitch;
              unsigned lo = *(const unsigned*)(kr + 2 * c), hi = *(const unsigned*)(kr + 32 + 2 * c);
              if (smp && is_lat) { const int kp = kstart + key; const f32x2 c2 = *(const f32x2*)(cs + kp * 32 + 2 * c), s2 = *(const f32x2*)(sn + kp * 32 + 2 * c);
                  const float x1a = bflo(lo), x1b = bfhi(lo), x2a = bflo(hi), x2b = bfhi(hi);
                  lo = pk2(x1a * c2.x - x2a * s2.x, x1b * c2.y - x2b * s2.y); hi = pk2(x1a * s2.x + x2a * c2.x, x1b * s2.y + x2b * c2.y); }
              *(LAS unsigned*)(Ks + key * 72 + 2 * c) = lo; *(LAS unsigned*)(Ks + key * 72 + 32 + 2 * c) = hi;
              const v2u vv = *(const v2u*)(vbase + (size_t)key * pitch + 4 * c);
              Vt[(4 * c + 0) * 40 + key] = (bf16)(vv.x & 0xffffu); Vt[(4 * c + 1) * 40 + key] = (bf16)(vv.x >> 16);
              Vt[(4 * c + 2) * 40 + key] = (bf16)(vv.y & 0xffffu); Vt[(4 * c + 3) * 40 + key] = (bf16)(vv.y >> 16); }
            __syncthreads();
            f32x16 S;
#pragma unroll
            for (int i = 0; i < 16; ++i) S[i] = 0.f;
#pragma unroll
            for (int ks = 0; ks < 4; ++ks) { const bf16x8 a = *(const LAS bf16x8*)(Ks + n * 72 + 16 * ks + 8 * half); S = __builtin_amdgcn_mfma_f32_32x32x16_bf16(a, qf[ks], S, 0, 0, 0); }
            if (smp && is_lat) {
#pragma unroll
                for (int i = 0; i < 16; ++i) { const int dd = qpos - (kstart + crow(i, half)); if (dd > 128 || dd < -128) S[i] = -INFINITY; }
            }
            float mx = S[0];
#pragma unroll
            for (int i = 1; i < 16; ++i) mx = fmaxf(mx, S[i]);
            mx = fmaxf(mx, __shfl_xor(mx, 32));
            const float m_new = fmaxf(m_run, mx), alpha = __builtin_amdgcn_exp2f(m_run - m_new);
            float rs = 0.f;
#pragma unroll
            for (int i = 0; i < 16; ++i) { S[i] = __builtin_amdgcn_exp2f(S[i] - m_new); rs += S[i]; }
            rs += __shfl_xor(rs, 32);
            l_run = l_run * alpha + rs; m_run = m_new;
#pragma unroll
            for (int i = 0; i < 16; ++i) { O0[i] *= alpha; O1[i] *= alpha; }
            bf16x8 pb[2];
#pragma unroll
            for (int t2 = 0; t2 < 2; ++t2) { v4u w;
#pragma unroll
                for (int e = 0; e < 4; ++e) w[e] = pk2(S[8 * t2 + 2 * e], S[8 * t2 + 2 * e + 1]);
                pb[t2] = __builtin_bit_cast(bf16x8, w); }
#pragma unroll
            for (int t2 = 0; t2 < 2; ++t2) {
                { const LAS bf16* vp = Vt + n * 40 + 16 * t2 + 4 * half; const v2u lo = *(const LAS v2u*)vp, hi = *(const LAS v2u*)(vp + 8);
                  const v4u a = (v4u){lo.x, lo.y, hi.x, hi.y}; O0 = __builtin_amdgcn_mfma_f32_32x32x16_bf16(__builtin_bit_cast(bf16x8, a), pb[t2], O0, 0, 0, 0); }
                { const LAS bf16* vp = Vt + (32 + n) * 40 + 16 * t2 + 4 * half; const v2u lo = *(const LAS v2u*)vp, hi = *(const LAS v2u*)(vp + 8);
                  const v4u a = (v4u){lo.x, lo.y, hi.x, hi.y}; O1 = __builtin_amdgcn_mfma_f32_32x32x16_bf16(__builtin_bit_cast(bf16x8, a), pb[t2], O1, 0, 0, 0); }
            }
        }
        const float inv = 1.f / l_run;
        bf16* orow = o + (size_t)(row0 + qpos) * D + head * 64 + 4 * half;
#pragma unroll
        for (int gq = 0; gq < 4; ++gq) {
            v2u w0, w1; w0.x = pk2(O0[4 * gq] * inv, O0[4 * gq + 1] * inv); w0.y = pk2(O0[4 * gq + 2] * inv, O0[4 * gq + 3] * inv);
            w1.x = pk2(O1[4 * gq] * inv, O1[4 * gq + 1] * inv); w1.y = pk2(O1[4 * gq + 2] * inv, O1[4 * gq + 3] * inv);
            *(v2u*)(orow + 8 * gq) = w0; *(v2u*)(orow + 32 + 8 * gq) = w1;
        }
    }
}

__device__ __forceinline__ void scan_phase(const Params& p, LAS unsigned char* lds) {
    const int tid = opaque_tid(), lane = tid & 63, wave = __builtin_amdgcn_readfirstlane(tid >> 6);
    const bf16* z = (const bf16*)(p.ws + WS_Z);
    const float* lbt = (const float*)(p.ws + WS_LB);
    const int st = tid >> 5, c4 = (tid & 31) * 4, c2 = (tid & 31) * 2;
    for (int it = blockIdx.x; it < 768; it += gridDim.x) {
        const bool smp = it < 256; const int r = smp ? it : it - 256;
        const int half = r & 1, dir = (r >> 1) & 1, h = (r >> 2) & 7, b = r >> 5;
        const int L = smp ? 1024 : 256, row0 = smp ? MP + b * 1024 : b * 256;
        float* og = (float*)(p.ws + (dir ? WS_OB : WS_OF));
        float S[16];
        if (smp) { const float* s0 = p.state_hgrn + ((size_t)((b * 2 + dir) * 8 + h) * 128 + 16 * wave) * 128 + half * 64 + lane;
#pragma unroll
            for (int jj = 0; jj < 16; ++jj) S[jj] = s0[jj * 128];
        } else {
#pragma unroll
            for (int jj = 0; jj < 16; ++jj) S[jj] = 0.f;
        }
        const int colq = h * 128 + c4;
        const f32x4 lb4 = *(const f32x4*)(lbt + dir * 1024 + colq);
        const int nchunk = L >> 4;
        v2u rq, rf; unsigned rv;
#define SCAN_LOAD(c) do { const int tp_ = dir ? (L - 1 - ((c) * 16 + st)) : ((c) * 16 + st); const bf16* zr_ = z + (size_t)(row0 + tp_) * 5120; \
        rq = *(const v2u*)(zr_ + colq); rf = *(const v2u*)(zr_ + 2048 + dir * 1024 + colq); rv = *(const unsigned*)(zr_ + 1024 + h * 128 + half * 64 + c2); } while (0)
#define SCAN_STORE(bufi) do { LAS float* B_ = (LAS float*)(lds + (bufi) * 28672); \
        f32x4 q_, f_, k_; const float zq_[4] = {bflo(rq.x), bfhi(rq.x), bflo(rq.y), bfhi(rq.y)}, zf_[4] = {bflo(rf.x), bfhi(rf.x), bflo(rf.y), bfhi(rf.y)}; \
        _Pragma("unroll") for (int e_ = 0; e_ < 4; ++e_) { q_[e_] = silu_f(zq_[e_]) * 0.08838834764831845f; const float fv_ = lb4[e_] + (1.f - lb4[e_]) * sigmoid_f(zf_[e_]); f_[e_] = fv_; k_[e_] = 1.f - fv_; } \
        *(LAS f32x4*)(B_ + st * 128 + c4) = q_; *(LAS f32x4*)(B_ + 2048 + st * 128 + c4) = k_; *(LAS f32x4*)(B_ + 4096 + st * 128 + c4) = f_; \
        *(LAS f32x2*)(B_ + 6144 + st * 64 + c2) = (f32x2){bflo(rv), bfhi(rv)}; } while (0)
        SCAN_LOAD(0); SCAN_STORE(0);
        __syncthreads();
        for (int c = 0; c < nchunk; ++c) {
            const bool more = c + 1 < nchunk;
            if (more) SCAN_LOAD(c + 1);
            const LAS float* B = (const LAS float*)(lds + (c & 1) * 28672);
            LAS float* red = (LAS float*)(lds + 57344 + (c & 1) * 32768);
#pragma unroll
            for (int s2 = 0; s2 < 16; ++s2) {
                const float vv = B[6144 + s2 * 64 + lane];
                float acc = 0.f;
#pragma unroll
                for (int i4 = 0; i4 < 4; ++i4) {
                    const f32x4 q4 = *(const LAS f32x4*)(B + s2 * 128 + 16 * wave + 4 * i4), k4 = *(const LAS f32x4*)(B + 2048 + s2 * 128 + 16 * wave + 4 * i4), f4 = *(const LAS f32x4*)(B + 4096 + s2 * 128 + 16 * wave + 4 * i4);
#pragma unroll
                    for (int e = 0; e < 4; ++e) { const float sn_ = f4[e] * S[4 * i4 + e] + k4[e] * vv; S[4 * i4 + e] = sn_; acc += sn_ * q4[e]; }
                }
                red[(wave * 16 + s2) * 64 + lane] = acc;
            }
            if (more) SCAN_STORE((c + 1) & 1);
            __syncthreads();
            { float s0 = 0.f, s1 = 0.f;
#pragma unroll
              for (int w8 = 0; w8 < 8; ++w8) { const f32x2 t2 = *(const LAS f32x2*)(red + (w8 * 16 + st) * 64 + c2); s0 += t2.x; s1 += t2.y; }
              const int tp = dir ? (L - 1 - (c * 16 + st)) : (c * 16 + st);
              *(f32x2*)(og + (size_t)(row0 + tp) * D + h * 128 + half * 64 + c2) = (f32x2){s0, s1}; }
        }
#undef SCAN_LOAD
#undef SCAN_STORE
        if (!smp) { float* so = p.out + OUT_ST + ((size_t)((b * 2 + dir) * 8 + h) * 128 + 16 * wave) * 128 + half * 64 + lane;
#pragma unroll
            for (int jj = 0; jj < 16; ++jj) so[jj * 128] = S[jj]; }
        __syncthreads();
    }
}
__device__ __forceinline__ void hgate_phase(const Params& p) {
    const int tid = opaque_tid(), lane = tid & 63, wave = __builtin_amdgcn_readfirstlane(tid >> 6);
    const bf16* z = (const bf16*)(p.ws + WS_Z); bf16* o = (bf16*)(p.ws + WS_O);
    const float* of = (const float*)(p.ws + WS_OF); const float* ob = (const float*)(p.ws + WS_OB);
    for (int m = blockIdx.x * 8 + wave; m < M; m += gridDim.x * 8) {
        const f32x4* a = (const f32x4*)(of + (size_t)m * D + 16 * lane); const f32x4* bq = (const f32x4*)(ob + (size_t)m * D + 16 * lane);
        f32x4 v[4]; float ss = 0.f;
#pragma unroll
        for (int jj = 0; jj < 4; ++jj) { v[jj] = a[jj] + bq[jj]; ss += (v[jj].x * v[jj].x + v[jj].y * v[jj].y) + (v[jj].z * v[jj].z + v[jj].w * v[jj].w); }
        ss += __shfl_xor(ss, 1); ss += __shfl_xor(ss, 2); ss += __shfl_xor(ss, 4);
        const float rs = rsqrtf(ss * (1.f / 128.f) + EPS);
        const v4u g0 = *(const v4u*)(z + (size_t)m * 5120 + 4096 + 16 * lane), g1 = *(const v4u*)(z + (size_t)m * 5120 + 4096 + 16 * lane + 8);
        const f32x4* ng = (const f32x4*)(p.hgrn_norm_g + ((16 * lane) & 127));
        float r[16];
#pragma unroll
        for (int jj = 0; jj < 4; ++jj) { const f32x4 gg = ng[jj]; const unsigned ga = jj < 2 ? g0[2 * jj] : g1[2 * jj - 4], gb = jj < 2 ? g0[2 * jj + 1] : g1[2 * jj - 3];
            r[4 * jj] = v[jj].x * rs * gg.x * silu_f(bflo(ga)); r[4 * jj + 1] = v[jj].y * rs * gg.y * silu_f(bfhi(ga));
            r[4 * jj + 2] = v[jj].z * rs * gg.z * silu_f(bflo(gb)); r[4 * jj + 3] = v[jj].w * rs * gg.w * silu_f(bfhi(gb)); }
        v4u w0, w1; w0.x = pk2(r[0], r[1]); w0.y = pk2(r[2], r[3]); w0.z = pk2(r[4], r[5]); w0.w = pk2(r[6], r[7]);
        w1.x = pk2(r[8], r[9]); w1.y = pk2(r[10], r[11]); w1.z = pk2(r[12], r[13]); w1.w = pk2(r[14], r[15]);
        *(v4u*)(o + (size_t)m * D + 16 * lane) = w0; *(v4u*)(o + (size_t)m * D + 16 * lane + 8) = w1;
    }
}
#ifndef PROBE
#define PROBE 0
#endif
#if PROBE == 1
#define GSYNC() do { xcd_barrier(bar); xcd_barrier(bar); } while (0)
#else
#define GSYNC() xcd_barrier(bar)
#endif
__global__ void __launch_bounds__(NTHR, 2) fwd_megakernel(Params p) {
    extern __shared__ __attribute__((aligned(16))) unsigned char lds_raw[];
    cg::grid_group grid = cg::this_grid();
    LAS unsigned char* lds = (LAS unsigned char*)lds_raw;
    const int G = gridDim.x;
    { const int t0 = opaque_tid(); if (t0 < 64) ((LAS unsigned*)(lds + MISC_OFF))[t0] = 0u; }
    __syncthreads();
    const XcdBarrier bar = xcd_barrier_post((unsigned*)(p.ws + WS_CTL), (volatile LAS unsigned*)(lds + MISC_OFF) + 8);
    const float* mod = (const float*)(p.ws + WS_MOD);
    bf16* hn = (bf16*)(p.ws + WS_HN); bf16* zb = (bf16*)(p.ws + WS_Z); float* hb = (float*)(p.ws + WS_H); bf16* ob = (bf16*)(p.ws + WS_O);

    p0_prologue(p, lds);
#if PROBE == 2
    p0_prologue(p, lds);
#endif
    grid.sync();

#pragma unroll 1
    for (int li = 0; li < DEPTH; ++li) {
        const int kind = li % 3, jm = li / 3;
        const float* modl = mod + (size_t)li * 9 * 9216;
        const float* ng = p.norm_g + (size_t)li * 6 * 1024;
#pragma unroll 1
        for (int sub = 0; sub < 3; ++sub) {
            {
                const bool first = (li == 0 && sub == 0);
                const float* modh; const float* gpost; int gate_idx; float rscale;
                if (sub == 0) { modh = modl - 9 * 9216; gpost = ng - 6 * 1024 + 5 * 1024; gate_idx = 8; rscale = 0.5f; if (first) { modh = modl; gpost = ng; } }
                else if (sub == 1) { modh = modl; gpost = ng + 1 * 1024; gate_idx = 2; rscale = 0.5f; }
                else { modh = modl; gpost = ng + 3 * 1024; gate_idx = 5; rscale = 1.0f; }
                ew_phase(p, first, true, rscale, modh, gate_idx, gpost, modl, sub, ng + 2 * sub * 1024);
            }
            GSYNC();
            const bf16* A2; const bf16* B2; int K2;
            if (sub != 1) {
                const int wi = li * 2 + (sub >> 1);
                pg8::Gemm g{hn, (const bf16*)(p.ws + WS_FFNIN) + (size_t)wi * 5632 * 1024, M, 5632, 1024}; pg8::StaticOrder S; S.init(M, 5632, G, (int)blockIdx.x);
                EpiSwiGLU E{zb};
                pg8::gemm_phase<EpiSwiGLU, pg8::StaticOrder, true, true>(lds, g, S, E);
                GSYNC();
                A2 = zb; B2 = (const bf16*)(p.ws + WS_FFNOUT) + (size_t)wi * 1024 * 2816; K2 = 2816;
            } else {
                const bf16* Bi; int Ni; float* kout = nullptr; float* vout = nullptr;
                if (kind == 0) { Bi = (const bf16*)(p.ws + WS_QKV) + (size_t)jm * 1536 * 1024; Ni = 1536; kout = p.out + OUT_K + (size_t)jm * 65536; vout = p.out + OUT_V + (size_t)jm * 65536; B2 = (const bf16*)(p.ws + WS_AO) + (size_t)jm * 1024 * 1024; }
                else if (kind == 1) { Bi = (const bf16*)(p.ws + WS_CIN); Ni = 3072; B2 = (const bf16*)(p.ws + WS_COUT); }
                else { Bi = (const bf16*)(p.ws + WS_HIN); Ni = 5120; B2 = (const bf16*)(p.ws + WS_HOUT); }
                {
                    pg8::Gemm g{hn, Bi, M, Ni, 1024}; pg8::StaticOrder S; S.init(M, Ni, G, (int)blockIdx.x);
                    EpiZ E{zb, Ni, kout, vout};
                    pg8::gemm_phase<EpiZ, pg8::StaticOrder, true, true>(lds, g, S, E);
                }
                GSYNC();
                if (kind == 0) { attn_phase(p, lds, jm);
#if PROBE == 4
                    attn_phase(p, lds, jm);
#endif
                }
                else if (kind == 1) conv_phase(p);
                else { scan_phase(p, lds);
#if PROBE == 3
                    scan_phase(p, lds);
#endif
                    GSYNC(); hgate_phase(p); }
                GSYNC();
                A2 = ob; K2 = 1024;
            }
            {
                pg8::Gemm g{A2, B2, M, 1024, K2}; pg8::StaticOrder S; S.init(M, 1024, G, (int)blockIdx.x);
                EpiF32 E{hb};
                pg8::gemm_phase<EpiF32, pg8::StaticOrder, true, true>(lds, g, S, E);
            }
            GSYNC();
        }
    }
    ew_phase(p, false, false, 0.5f, mod + (size_t)3 * 9 * 9216, 8, p.norm_g + (size_t)(3 * 6 + 5) * 1024, mod, 0, p.norm_g);
}

extern "C" void kernel_launch(void* const* d_in, const int* in_sizes, int n_in, void* d_out, int out_size, void* d_ws, size_t ws_size, hipStream_t stream) {
    static int grid = 0;
    if (grid == 0) {
        if (n_in != 23 || ws_size < WS_END) { fprintf(stderr, "kernel_launch: expected 23 inputs and >= %zu bytes of workspace; got %d, %zu\n", (size_t)WS_END, n_in, ws_size); grid = -1; return; }
        int dev = 0, cus = 0, per_cu = 0;
        hipGetDevice(&dev); hipDeviceGetAttribute(&cus, hipDeviceAttributeMultiprocessorCount, dev);
        if (hipFuncSetAttribute((const void*)fwd_megakernel, hipFuncAttributeMaxDynamicSharedMemorySize, LDS_BYTES) != hipSuccess) { fprintf(stderr, "kernel_launch: hipFuncSetAttribute failed\n"); grid = -1; return; }
        if (hipOccupancyMaxActiveBlocksPerMultiprocessor(&per_cu, (const void*)fwd_megakernel, NTHR, LDS_BYTES) != hipSuccess || per_cu < 1) { fprintf(stderr, "kernel_launch: occupancy query gave %d\n", per_cu); per_cu = 1; }
        (void)hipGetLastError();
        grid = cus * per_cu;
    }
    if (grid < 0) return;
    if (hipMemsetAsync((char*)d_ws + WS_CTL, 0, CTL_BYTES, stream) != hipSuccess) { fprintf(stderr, "kernel_launch: hipMemsetAsync failed\n"); return; }
    Params p{};
    const float** pp = (const float**)&p;
    for (int i = 0; i < 23; ++i) pp[i] = (const float*)d_in[i];
    p.out = (float*)d_out; p.ws = (unsigned char*)d_ws;
    void* args[] = {&p};
    hipError_t e = hipLaunchCooperativeKernel((const void*)fwd_megakernel, dim3(grid), dim3(NTHR), args, LDS_BYTES, stream);
    if (e != hipSuccess) fprintf(stderr, "cooperative launch failed: %s (grid %d)\n", hipGetErrorString(e), grid);
}
```

```cpp
#define PROBE 0
#include <hip/hip_runtime.h>
#include <hip/hip_cooperative_groups.h>
#include <cstdio>
#include <cstdint>
namespace cg = cooperative_groups;
__device__ __forceinline__ int opaque_tid() { int t = threadIdx.x; asm volatile("" : "+v"(t)); return t; }
namespace pg8 {
#define PG8_LAS __attribute__((address_space(3)))
typedef unsigned short bf16_t;
typedef short bf16x8 __attribute__((ext_vector_type(8)));
typedef float f32x4 __attribute__((ext_vector_type(4)));
typedef unsigned u32x4 __attribute__((ext_vector_type(4)));
constexpr int BM = 256, BK = 64, HALF = 128, HTB = HALF * BK * 2  , STAGE_BYTES = 8 * HTB, NXCD = 8, WGM = 8;

__host__ __device__ __forceinline__ int lds_byte(int r, int c) { const int st = (r >> 4) * 2 + (c >> 5), rr = r & 15, cc = c & 31, ob = rr * 64 + cc * 2; return st * 1024 + (ob ^ (((ob >> 9) & 1) << 5)); }
__host__ __device__ __forceinline__ void stage_rc(int b, int& R, int& C) { const int st = b / 1024, sb = b % 1024, swz = sb ^ (((sb >> 9) & 1) << 5); R = (st >> 1) * 16 + swz / 64; C = (st & 1) * 32 + (swz % 64) / 2; }
__host__ __device__ __forceinline__ int perm32(int rho) { const int n = rho >> 4, i = rho & 15; return 8 * (i >> 2) + 4 * n + (i & 3); }

struct Unit { int pm, pn; };
struct Gemm { const bf16_t* A; const bf16_t* Bt; int M, N, K; };

struct StaticOrder {
    int nM, nN, nwg, G, c;
    __host__ __device__ void init(int M, int N, int G_, int c_) { nM = M / BM; nN = N / BM; nwg = nM * nN; G = G_; c = c_; }
    __host__ __device__ bool next(int i, Unit& u) const {
        const long L = (long)i * G + c; if (L >= nwg) return false;
        int wgid = (int)L; { const int q = nwg / NXCD, r = nwg % NXCD, xcd = wgid % NXCD, off = wgid / NXCD; wgid = (xcd < r ? xcd * (q + 1) : r * (q + 1) + (xcd - r) * q) + off; }
        const int nig = WGM * nN, gid = wgid / nig, fm = gid * WGM, gsz = (nM - fm) < WGM ? (nM - fm) : WGM;
        u.pm = fm + ((wgid % nig) % gsz); u.pn = (wgid % nig) / gsz; return true;
    }
    __device__ __forceinline__ void a_ready(const Unit&) const {}
    __device__ __forceinline__ void done(const Unit&) const {}
};

__device__ __forceinline__ unsigned cvt_pk_bf16(float lo, float hi) { unsigned r; asm volatile("v_cvt_pk_bf16_f32 %0, %1, %2" : "=v"(r) : "v"(lo), "v"(hi)); return r; }
typedef float f32x2 __attribute__((ext_vector_type(2)));
template <class Epi, class Sched, bool ALIGN_EPI = false, bool SP2 = false>
__device__ __forceinline__ void gemm_phase(PG8_LAS unsigned char* lds, const Gemm g, const Sched& S, const Epi& E) {
    const int tid = opaque_tid(), wid = __builtin_amdgcn_readfirstlane(tid >> 6), lane = tid & 63, wr = wid >> 2, wc = wid & 3, fr = lane & 15, fq = lane >> 4;
    const int K = g.K, nt = K / BK;
    unsigned voffA[2], voffB[2];
#pragma unroll
    for (int i = 0; i < 2; ++i) { int R, C; stage_rc(tid * 16 + i * 8192, R, C); const int Rb = Epi::PERM ? ((R & ~31) + perm32(R & 31)) : R;
        voffA[i] = (unsigned)(R * K + C) * 2u; voffB[i] = (unsigned)(Rb * K + C) * 2u; }
    const size_t kstep = (size_t)(BK * 2);
    const size_t hstep = (size_t)HALF * K * 2;
    const size_t tstep = 2 * hstep;
    const unsigned ldsw = (unsigned)wid * 1024u;
    const int aoff = lds_byte(wr * 64 + fr, fq * 8), boff = lds_byte(wc * 32 + fr, fq * 8);
#define PG8_SA(b, h) (((b) * 2 + (h)) * HTB)
#define PG8_SB(b, h) ((4 + (b) * 2 + (h)) * HTB)
#define PG8_STAGE(bufoff, gbase, voff) do { _Pragma("unroll") for (int _i = 0; _i < 2; ++_i) \
        __builtin_amdgcn_global_load_lds((const unsigned*)((const char*)(gbase) + (voff)[_i]), (PG8_LAS unsigned*)(lds + (bufoff) + ldsw + _i * 8192), 16, 0, 0); } while (0)
#define PG8_LDA(dst, b, h) do { _Pragma("unroll") for (int m = 0; m < 4; ++m) _Pragma("unroll") for (int k = 0; k < 2; ++k) dst[m][k] = *(const PG8_LAS bf16x8*)(lds + PG8_SA(b, h) + aoff + m * 2048 + k * 1024); } while (0)
#define PG8_LDB(dst, b, h) do { _Pragma("unroll") for (int n = 0; n < 2; ++n) _Pragma("unroll") for (int k = 0; k < 2; ++k) dst[n][k] = *(const PG8_LAS bf16x8*)(lds + PG8_SB(b, h) + boff + n * 2048 + k * 1024); } while (0)
#define PG8_MMA(ai, bj, At, Bt) do { __builtin_amdgcn_s_setprio(1); _Pragma("unroll") for (int m = 0; m < 4; ++m) _Pragma("unroll") for (int n = 0; n < 2; ++n) _Pragma("unroll") for (int k = 0; k < 2; ++k) \
        acc[ai][bj][m][n] = __builtin_amdgcn_mfma_f32_16x16x32_bf16(Bt[n][k], At[m][k], acc[ai][bj][m][n], 0, 0, 0); __builtin_amdgcn_s_setprio(0); } while (0)
#define PG8_WAIT_V(n) asm volatile("s_waitcnt vmcnt(" #n ")" ::: "memory")
#define PG8_WAIT_L(n) asm volatile("s_waitcnt lgkmcnt(" #n ")" ::: "memory")
#define PG8_BAR __builtin_amdgcn_s_barrier()
#define PG8_SCHED __builtin_amdgcn_sched_barrier(0)
    Unit cur, nxt; int ui = 0;
    if (!S.next(0, cur)) return;
    f32x4 acc[2][2][4][2];
#pragma unroll
    for (int a = 0; a < 2; ++a)
#pragma unroll
        for (int b = 0; b < 2; ++b)
#pragma unroll
            for (int m = 0; m < 4; ++m)
#pragma unroll
                for (int n = 0; n < 2; ++n) acc[a][b][m][n] = (f32x4){0.f, 0.f, 0.f, 0.f};
    bf16x8 At[4][2], B0[2][2], B1[2][2];
    const char* cA = (const char*)g.A + (size_t)cur.pm * tstep; const char* cB = (const char*)g.Bt + (size_t)cur.pn * tstep;
    S.a_ready(cur);
    if constexpr (SP2) {
        PG8_STAGE(PG8_SB(0, 0), cB, voffB); PG8_STAGE(PG8_SB(0, 1), cB + hstep, voffB); PG8_STAGE(PG8_SA(0, 0), cA, voffA); PG8_STAGE(PG8_SA(0, 1), cA + hstep, voffA);
        if (wr == 1) PG8_BAR;
        PG8_WAIT_V(2); PG8_BAR;
        PG8_STAGE(PG8_SB(1, 0), cB + kstep, voffB); PG8_STAGE(PG8_SA(1, 0), cA + kstep, voffA); PG8_STAGE(PG8_SB(1, 1), cB + hstep + kstep, voffB);
        PG8_WAIT_V(6); PG8_BAR;
    } else {
        PG8_STAGE(PG8_SB(0, 0), cB, voffB); PG8_STAGE(PG8_SA(0, 0), cA, voffA); PG8_STAGE(PG8_SB(0, 1), cB + hstep, voffB); PG8_STAGE(PG8_SA(0, 1), cA + hstep, voffA);
        if (wr == 1) PG8_BAR;
        PG8_WAIT_V(4); PG8_BAR;
        PG8_STAGE(PG8_SB(1, 0), cB + kstep, voffB); PG8_STAGE(PG8_SA(1, 0), cA + kstep, voffA); PG8_STAGE(PG8_SB(1, 1), cB + hstep + kstep, voffB);
        PG8_WAIT_V(6); PG8_BAR;
    }
    for (;;) {
        const bool has_next = S.next(ui + 1, nxt);
        const char* nA = has_next ? (const char*)g.A + (size_t)nxt.pm * tstep : cA; const char* nB = has_next ? (const char*)g.Bt + (size_t)nxt.pn * tstep : cB;
        for (int t = 0; t < nt; t += 2) {
            const bool last = (t == nt - 2);
            const char* a1 = cA + (size_t)(t + 1) * kstep;
            const char* a2 = last ? nA : cA + (size_t)(t + 2) * kstep; const char* b2 = last ? nB : cB + (size_t)(t + 2) * kstep;
            const char* a3 = a2 + kstep; const char* b3 = b2 + kstep;
            if (last && has_next) S.a_ready(nxt);
            if constexpr (SP2) {
            PG8_LDB(B0, 0, 0); PG8_LDB(B1, 0, 1); PG8_SCHED; PG8_LDA(At, 0, 0); PG8_STAGE(PG8_SA(1, 1), a1 + hstep, voffA);
            PG8_WAIT_V(8); PG8_WAIT_L(0); PG8_BAR; PG8_MMA(0, 0, At, B0); PG8_MMA(0, 1, At, B1); PG8_BAR; PG8_SCHED;
            PG8_LDA(At, 0, 1); PG8_STAGE(PG8_SB(0, 0), b2, voffB); PG8_STAGE(PG8_SB(0, 1), b2 + hstep, voffB); PG8_STAGE(PG8_SA(0, 0), a2, voffA);
            PG8_WAIT_V(8); PG8_WAIT_L(0); PG8_BAR; PG8_MMA(1, 0, At, B0); PG8_MMA(1, 1, At, B1); PG8_BAR; PG8_SCHED;
            PG8_LDB(B0, 1, 0); PG8_LDB(B1, 1, 1); PG8_SCHED; PG8_LDA(At, 1, 0); PG8_STAGE(PG8_SA(0, 1), a2 + hstep, voffA);
            PG8_WAIT_V(8); PG8_WAIT_L(0); PG8_BAR; PG8_MMA(0, 0, At, B0); PG8_MMA(0, 1, At, B1); PG8_BAR; PG8_SCHED;
            PG8_LDA(At, 1, 1); PG8_STAGE(PG8_SB(1, 0), b3, voffB); PG8_STAGE(PG8_SB(1, 1), b3 + hstep, voffB); PG8_STAGE(PG8_SA(1, 0), a3, voffA);
            PG8_WAIT_V(8); PG8_WAIT_L(0); PG8_BAR; PG8_MMA(1, 0, At, B0); PG8_MMA(1, 1, At, B1); PG8_BAR; PG8_SCHED;
            } else {
            PG8_LDB(B0, 0, 0); PG8_SCHED; PG8_LDA(At, 0, 0); PG8_STAGE(PG8_SA(1, 1), a1 + hstep, voffA);
            PG8_WAIT_L(8); PG8_BAR; PG8_WAIT_L(0); PG8_MMA(0, 0, At, B0); PG8_BAR; PG8_SCHED;
            PG8_LDB(B1, 0, 1); PG8_STAGE(PG8_SB(0, 0), b2, voffB);
            PG8_BAR; PG8_WAIT_L(0); PG8_MMA(0, 1, At, B1); PG8_BAR;
            PG8_LDA(At, 0, 1); PG8_STAGE(PG8_SA(0, 0), a2, voffA);
            PG8_BAR; PG8_WAIT_L(0); PG8_MMA(1, 0, At, B0); PG8_BAR; PG8_SCHED;
            PG8_STAGE(PG8_SB(0, 1), b2 + hstep, voffB);
            PG8_WAIT_V(6); PG8_BAR; PG8_MMA(1, 1, At, B1); PG8_BAR;
            PG8_LDB(B0, 1, 0); PG8_SCHED; PG8_LDA(At, 1, 0); PG8_STAGE(PG8_SA(0, 1), a2 + hstep, voffA);
            PG8_WAIT_L(8); PG8_BAR; PG8_WAIT_L(0); PG8_MMA(0, 0, At, B0); PG8_BAR; PG8_SCHED;
            PG8_LDB(B1, 1, 1); PG8_STAGE(PG8_SB(1, 0), b3, voffB);
            PG8_BAR; PG8_WAIT_L(0); PG8_MMA(0, 1, At, B1); PG8_BAR;
            PG8_LDA(At, 1, 1); PG8_STAGE(PG8_SA(1, 0), a3, voffA);
            PG8_BAR; PG8_WAIT_L(0); PG8_MMA(1, 0, At, B0); PG8_BAR; PG8_SCHED;
            PG8_STAGE(PG8_SB(1, 1), b3 + hstep, voffB);
            PG8_WAIT_V(6); PG8_BAR; PG8_MMA(1, 1, At, B1); PG8_BAR;
            }
        }
        if constexpr (ALIGN_EPI) { if (wr == 0) PG8_BAR; }
        if constexpr (!Epi::AFTER_DRAIN) { E(acc, cur, wr, wc, fr, fq); S.done(cur); }
        if (!has_next) break;
#pragma unroll
        for (int a = 0; a < 2; ++a)
#pragma unroll
            for (int b = 0; b < 2; ++b)
#pragma unroll
                for (int m = 0; m < 4; ++m)
#pragma unroll
                    for (int n = 0; n < 2; ++n) acc[a][b][m][n] = (f32x4){0.f, 0.f, 0.f, 0.f};
        cur = nxt; cA = nA; cB = nB; ++ui;
        if constexpr (ALIGN_EPI) { if (wr == 1) PG8_BAR; }
    }
    PG8_WAIT_V(0);
    if constexpr (!ALIGN_EPI) { if (wr == 0) PG8_BAR; }
    PG8_BAR;
    if constexpr (Epi::AFTER_DRAIN) { E.fused(acc, cur, wr, wc, fr, fq, lds, wid, lane); S.done(cur); }
#undef PG8_SA
#undef PG8_SB
#undef PG8_STAGE
#undef PG8_LDA
#undef PG8_LDB
#undef PG8_MMA
#undef PG8_WAIT_V
#undef PG8_WAIT_L
#undef PG8_BAR
#undef PG8_SCHED
}
}
#define LAS __attribute__((address_space(3)))
typedef unsigned short bf16;
typedef unsigned v4u __attribute__((ext_vector_type(4)));
typedef unsigned v2u __attribute__((ext_vector_type(2)));
typedef float f32x4 __attribute__((ext_vector_type(4)));
typedef float f32x2 __attribute__((ext_vector_type(2)));
typedef float f32x16 __attribute__((ext_vector_type(16)));
typedef short bf16x8 __attribute__((ext_vector_type(8)));

constexpr int NTHR = 512;
constexpr int D = 1024, MP = 4096, MS = 8192, M = MP + MS, DFF = 2816, DEPTH = 4;
constexpr int LDS_BYTES = 147456;
constexpr float EPS = 1e-6f;
constexpr float LOG2E = 1.4426950408889634f;

constexpr size_t MiB = 1u << 20;
constexpr size_t WS_FFNIN = 0;
constexpr size_t WS_FFNOUT = WS_FFNIN + 8ull * 5632 * 1024 * 2;
constexpr size_t WS_QKV = WS_FFNOUT + 8ull * 1024 * 2816 * 2;
constexpr size_t WS_AO = WS_QKV + 2ull * 1536 * 1024 * 2;
constexpr size_t WS_CIN = WS_AO + 2ull * 1024 * 1024 * 2;
constexpr size_t WS_COUT = WS_CIN + 3072ull * 1024 * 2;
constexpr size_t WS_HIN = WS_COUT + 1024ull * 1024 * 2;
constexpr size_t WS_HOUT = WS_HIN + 5120ull * 1024 * 2;
constexpr size_t WS_MOD = WS_HOUT + 1024ull * 1024 * 2;
constexpr size_t WS_ROPE = WS_MOD + 2 * MiB;
constexpr size_t WS_LB = WS_ROPE + MiB;
constexpr size_t WS_CK = WS_LB + MiB;
constexpr size_t WS_CV = WS_CK + 2 * MiB;
constexpr size_t WS_HN = WS_CV + 2 * MiB;
constexpr size_t WS_Z = WS_HN + 24 * MiB;
constexpr size_t WS_H = WS_Z + 120 * MiB;
constexpr size_t WS_O = WS_H + 48 * MiB;
constexpr size_t WS_OF = WS_O + 24 * MiB;
constexpr size_t WS_OB = WS_OF + 48 * MiB;
constexpr size_t WS_CTL = WS_OB + 48 * MiB, CTL_BYTES = 16384;
constexpr size_t WS_END = WS_CTL + MiB;
constexpr int MISC_OFF = 131072 + 320;

constexpr size_t OUT_YS = (size_t)MP * D, OUT_K = (size_t)M * D, OUT_V = OUT_K + 16ull * 2 * 256 * 256, OUT_ST = OUT_V + 16ull * 2 * 256 * 256;

struct Params {
    const float *x_prompt, *x_sample, *cache_k, *cache_v, *state_hgrn, *c, *c_ctx, *w_ada, *b_ada, *norm_g, *w_ffn_in, *w_ffn_out,
        *w_attn_qkv, *w_attn_o, *attn_sink, *w_conv_in, *conv_w, *conv_b, *w_conv_out, *w_hgrn_in, *hgrn_lb, *hgrn_norm_g, *w_hgrn_out;
    float* out; unsigned char* ws;
};

__device__ __forceinline__ unsigned f2bf(float f) { unsigned u = __builtin_bit_cast(unsigned, f); return (u + 0x7fffu + ((u >> 16) & 1u)) >> 16; }
__device__ __forceinline__ unsigned pk2(float lo, float hi) { return f2bf(lo) | (f2bf(hi) << 16); }
__device__ __forceinline__ float bflo(unsigned u) { return __uint_as_float(u << 16); }
__device__ __forceinline__ float bfhi(unsigned u) { return __uint_as_float(u & 0xffff0000u); }
__device__ __forceinline__ float sigmoid_f(float a) { return __builtin_amdgcn_rcpf(1.f + __expf(-a)); }
__device__ __forceinline__ float silu_f(float a) { return a * sigmoid_f(a); }
__device__ __forceinline__ float wave_sum(float v) {
#pragma unroll
    for (int o = 1; o < 64; o <<= 1) v += __shfl_xor(v, o);
    return v;
}
#define LDS_WAIT() asm volatile("s_waitcnt lgkmcnt(0)" ::: "memory")

struct EpiSwiGLU {
    static constexpr bool PERM = true, AFTER_DRAIN = false;
    bf16* O;
    __device__ __forceinline__ void operator()(const pg8::f32x4 (&acc)[2][2][4][2], const pg8::Unit& u, int wr, int wc, int fr, int fq) const {
        const int row0 = u.pm * 256 + wr * 64 + fr, col0 = u.pn * 128 + wc * 32 + 8 * fq;
#pragma unroll
        for (int ai = 0; ai < 2; ++ai)
#pragma unroll
            for (int m = 0; m < 4; ++m) {
                bf16* rowp = O + (size_t)(row0 + ai * 128 + m * 16) * DFF + col0;
                const pg8::f32x4 a0 = acc[ai][0][m][0], a1 = acc[ai][0][m][1], b0 = acc[ai][1][m][0], b1 = acc[ai][1][m][1];
                v4u w;
                w.x = pg8::cvt_pk_bf16(silu_f(a0[0]) * b0[0], silu_f(a0[1]) * b0[1]); w.y = pg8::cvt_pk_bf16(silu_f(a0[2]) * b0[2], silu_f(a0[3]) * b0[3]);
                w.z = pg8::cvt_pk_bf16(silu_f(a1[0]) * b1[0], silu_f(a1[1]) * b1[1]); w.w = pg8::cvt_pk_bf16(silu_f(a1[2]) * b1[2], silu_f(a1[3]) * b1[3]);
                *(v4u*)rowp = w;
            }
    }
};
struct EpiF32 {
    static constexpr bool PERM = false, AFTER_DRAIN = false;
    float* O;
    __device__ __forceinline__ void operator()(const pg8::f32x4 (&acc)[2][2][4][2], const pg8::Unit& u, int wr, int wc, int fr, int fq) const {
        const int row0 = u.pm * 256 + wr * 64 + fr, col0 = u.pn * 256 + wc * 32 + 4 * fq;
#pragma unroll
        for (int ai = 0; ai < 2; ++ai)
#pragma unroll
            for (int m = 0; m < 4; ++m) {
                float* rowp = O + (size_t)(row0 + ai * 128 + m * 16) * D + col0;
#pragma unroll
                for (int bj = 0; bj < 2; ++bj)
#pragma unroll
                    for (int n = 0; n < 2; ++n) *(pg8::f32x4*)(rowp + bj * 128 + n * 16) = acc[ai][bj][m][n];
            }
    }
};
struct EpiZ {
    static constexpr bool PERM = true, AFTER_DRAIN = false;
    bf16* O; int ldc; float* kout; float* vout;
    __device__ __forceinline__ void operator()(const pg8::f32x4 (&acc)[2][2][4][2], const pg8::Unit& u, int wr, int wc, int fr, int fq) const {
        const int row0 = u.pm * 256 + wr * 64 + fr, col0 = u.pn * 256 + wc * 32 + 8 * fq;
        const bool kv = (kout != nullptr) && u.pn >= 4 && u.pm < 16;
        float* kvb = (u.pn == 4) ? kout : vout;
#pragma unroll
        for (int ai = 0; ai < 2; ++ai)
#pragma unroll
            for (int m = 0; m < 4; ++m) {
                const int row = row0 + ai * 128 + m * 16;
                bf16* rowp = O + (size_t)row * ldc + col0;
#pragma unroll
                for (int bj = 0; bj < 2; ++bj) {
                    const pg8::f32x4 v0 = acc[ai][bj][m][0], v1 = acc[ai][bj][m][1];
                    v4u w; w.x = pg8::cvt_pk_bf16(v0[0], v0[1]); w.y = pg8::cvt_pk_bf16(v0[2], v0[3]); w.z = pg8::cvt_pk_bf16(v1[0], v1[1]); w.w = pg8::cvt_pk_bf16(v1[2], v1[3]);
                    *(v4u*)(rowp + bj * 128) = w;
                    if (kv) { float* dst = kvb + (size_t)(row >> 8) * (2 * 65536) + (size_t)(row & 255) * 256 + wc * 32 + 8 * fq + bj * 128;
                        *(pg8::f32x4*)dst = v0; *(pg8::f32x4*)(dst + 4) = v1; }
                }
            }
    }
};
#define XB_TMO      128
#define XB_XCNT(j)  (256  + 64 * (j))
#define XB_XSUB(j)  (1280 + 64 * (j))
#define XB_XGEN(j)  (2304 + 64 * (j))
#define XB_TOP      3328
#define XB_TOPGEN   3392
#define XCD_BAR_WORDS 3456
#define XB_SPIN_CAP (1u << 18)

__device__ __forceinline__ unsigned xb_ld(unsigned* p)              { return __hip_atomic_load(p, __ATOMIC_RELAXED, __HIP_MEMORY_SCOPE_AGENT); }
__device__ __forceinline__ unsigned xb_add(unsigned* p, unsigned v) { return __hip_atomic_fetch_add(p, v, __ATOMIC_RELAXED, __HIP_MEMORY_SCOPE_AGENT); }
__device__ __forceinline__ unsigned xb_xcc_id() { return (unsigned)__builtin_amdgcn_s_getreg((3 << 11) | 20) & 0xFu; }
#define XB_SPIN(cond, bar) do { unsigned _sp = 0; while (cond) { __builtin_amdgcn_s_sleep(1); \
    if ((++_sp & 255u) == 0u) { if (xb_ld(&(bar)[XB_TMO])) break; if (_sp > XB_SPIN_CAP) { atomicAdd(&(bar)[XB_TMO], 1u); break; } } } } while (0)

struct XcdBarrier {
    unsigned* bar; unsigned x;
    volatile LAS unsigned* st;
};

__device__ __forceinline__ XcdBarrier xcd_barrier_post(unsigned* bar, volatile LAS unsigned* st) {
    XcdBarrier b; b.bar = bar; b.x = xb_xcc_id(); b.st = st;
    if (threadIdx.x == 0) (void)xb_add(&bar[XB_XCNT(b.x)], 1u);
    return b;
}
__device__ __forceinline__ void xcd_barrier_complete(unsigned* bar, unsigned x, unsigned& nloc, unsigned& nx) {
    const unsigned G = gridDim.x * gridDim.y * gridDim.z;
    unsigned sum, cnt, mine, sp = 0u;
    for (;;) {
        sum = 0u; cnt = 0u; mine = 0u;
#pragma unroll
        for (unsigned j = 0; j < 16; ++j) { const unsigned c = xb_ld(&bar[XB_XCNT(j)]); sum += c; cnt += (c > 0u) ? 1u : 0u; mine = (j == x) ? c : mine; }
        if (sum == G) break;
        __builtin_amdgcn_s_sleep(1);
        if ((++sp & 255u) == 0u) { if (xb_ld(&bar[XB_TMO])) break; if (sp > XB_SPIN_CAP) { atomicAdd(&bar[XB_TMO], 1u); break; } }
    }
    nloc = mine > 0u ? mine : 1u; nx = cnt > 0u ? cnt : 1u;
}

__device__ __forceinline__ void xcd_barrier(const XcdBarrier& b) {
    asm volatile("s_waitcnt vmcnt(0)" ::: "memory");
    __syncthreads();
    if (threadIdx.x == 0) {
        unsigned* bar = b.bar;
        __builtin_amdgcn_s_waitcnt(0);
        unsigned nloc = b.st[0], nx = b.st[1];
        if (nloc == 0u) { xcd_barrier_complete(bar, b.x, nloc, nx); b.st[0] = nloc; b.st[1] = nx; }
        const unsigned old = xb_add(&bar[XB_XSUB(b.x)], 1u);
        const unsigned gen = old / nloc;
        if (old + 1u == (gen + 1u) * nloc) {
            __builtin_amdgcn_fence(__ATOMIC_RELEASE, "agent");
            asm volatile("s_waitcnt vmcnt(0)" ::: "memory");
            const unsigned og = xb_add(&bar[XB_TOP], 1u);
            const unsigned tg = og / nx;
            if (og + 1u == (tg + 1u) * nx) xb_add(&bar[XB_TOPGEN], 1u);
            else XB_SPIN(xb_ld(&bar[XB_TOPGEN]) == tg, bar);
            __builtin_amdgcn_fence(__ATOMIC_ACQUIRE, "agent");
            xb_add(&bar[XB_XGEN(b.x)], 1u);
            asm volatile("s_waitcnt vmcnt(0)" ::: "memory");
        } else {
            XB_SPIN(xb_ld(&bar[XB_XGEN(b.x)]) == gen, bar);
            __builtin_amdgcn_fence(__ATOMIC_ACQUIRE, "agent");
            asm volatile("s_waitcnt vmcnt(0)" ::: "memory");
        }
    }
    __syncthreads();
}
__device__ __forceinline__ void p0_transpose_item(const float* W, int K, int N, bf16* WT, int k0, int n0, int drow0, LAS float* scr, int lane) {
#pragma unroll 8
    for (int i = 0; i < 32; ++i) { const int kk = 2 * i + (lane >> 5); scr[kk * 33 + (lane & 31)] = W[(size_t)(k0 + kk) * N + n0 + (lane & 31)]; }
    LDS_WAIT(); asm volatile("" ::: "memory");
    const int c = lane & 7;
#pragma unroll
    for (int j = 0; j < 4; ++j) { const int n = (lane >> 3) + 8 * j; const LAS float* s = scr + (8 * c) * 33 + n;
        v4u o; o.x = pk2(s[0 * 33], s[1 * 33]); o.y = pk2(s[2 * 33], s[3 * 33]); o.z = pk2(s[4 * 33], s[5 * 33]); o.w = pk2(s[6 * 33], s[7 * 33]);
        *(v4u*)(WT + (size_t)(drow0 + n) * K + k0 + 8 * c) = o; }
    LDS_WAIT(); asm volatile("" ::: "memory");
}

constexpr int IT_FI = 16 * 176, IT_FO = 44 * 32, IT_QKV = 16 * 48, IT_SQ = 16 * 32, IT_CI = 16 * 96, IT_HI = 16 * 160;
constexpr int C0 = 8 * IT_FI, C1 = C0 + 8 * IT_FO, C2 = C1 + 2 * IT_QKV, C3 = C2 + 2 * IT_SQ, C4 = C3 + IT_CI, C5 = C4 + IT_SQ, C6 = C5 + IT_HI, C7 = C6 + IT_SQ;

__device__ __forceinline__ void p0_prologue(const Params& p, LAS unsigned char* lds) {
    const int tid = opaque_tid(), lane = tid & 63, wave = __builtin_amdgcn_readfirstlane(tid >> 6);
    const int gt = blockIdx.x * NTHR + tid, NGT = gridDim.x * NTHR;
    const int gw = blockIdx.x * 8 + wave, NGW = gridDim.x * 8;
    { float* cs = (float*)(p.ws + WS_ROPE); float* sn = cs + 1024 * 32;
      for (int i = gt; i < 1024 * 32; i += NGT) { const int t = i >> 5, k = i & 31; const float pos = (float)(k < 16 ? (t >> 6) : (t & 63));
          const float inv = exp2f(-(float)(k & 15) * (13.287712379549449f / 16.0f));
          const float ang = pos * inv; cs[i] = __cosf(ang); sn[i] = __sinf(ang); } }
    { float* lbt = (float*)(p.ws + WS_LB);
      for (int i = gt; i < 2048; i += NGT) { const int dir = i >> 10, d = i & 1023; const float* q = p.hgrn_lb + (size_t)dir * DEPTH * 1024 + d;
          const float a0 = q[0], a1 = q[1024], a2 = q[2048], a3 = q[3072]; const float mx = fmaxf(fmaxf(a0, a1), fmaxf(a2, a3));
          const float e0 = expf(a0 - mx), e1 = expf(a1 - mx), e2 = expf(a2 - mx), e3 = expf(a3 - mx);
          lbt[i] = (e1 + e2) / (e0 + e1 + e2 + e3); } }
    { bf16* ck = (bf16*)(p.ws + WS_CK); bf16* cv = (bf16*)(p.ws + WS_CV);
      for (int i = gt; i < 8 * 2 * 256 * 256 / 4; i += NGT) { const f32x4 a = ((const f32x4*)p.cache_k)[i], b = ((const f32x4*)p.cache_v)[i];
          v2u wa, wb; wa.x = pk2(a.x, a.y); wa.y = pk2(a.z, a.w); wb.x = pk2(b.x, b.y); wb.y = pk2(b.z, b.w);
          ((v2u*)ck)[i] = wa; ((v2u*)cv)[i] = wb; } }
    { LAS float* sc = (LAS float*)lds;
      LAS float* red = (LAS float*)(lds + 49152);
      for (int i = tid; i < 9 * 1024; i += NTHR) { const int cnd = i >> 10, k = i & 1023; const float v = cnd == 0 ? p.c_ctx[k] : p.c[(cnd - 1) * 1024 + k]; sc[k * 12 + cnd] = v / (1.f + expf(-v)); }
      __syncthreads();
      float* mod = (float*)(p.ws + WS_MOD);
      for (int task = blockIdx.x; task < 288; task += gridDim.x) {
          const int li = task / 72, cgp = task % 72;
          const float* W = p.w_ada + (size_t)li * 1024 * 9216 + cgp * 128 + 2 * lane;
          float a0[9], a1[9];
#pragma unroll
          for (int q = 0; q < 9; ++q) { a0[q] = 0.f; a1[q] = 0.f; }
          const int k0 = wave * 128;
#pragma unroll 8
          for (int k = k0; k < k0 + 128; ++k) {
              const f32x2 w = *(const f32x2*)(W + (size_t)k * 9216);
              const f32x4 s0 = *(const LAS f32x4*)(sc + k * 12), s1 = *(const LAS f32x4*)(sc + k * 12 + 4), s2 = *(const LAS f32x4*)(sc + k * 12 + 8);
              a0[0] += s0.x * w.x; a1[0] += s0.x * w.y; a0[1] += s0.y * w.x; a1[1] += s0.y * w.y; a0[2] += s0.z * w.x; a1[2] += s0.z * w.y; a0[3] += s0.w * w.x; a1[3] += s0.w * w.y;
              a0[4] += s1.x * w.x; a1[4] += s1.x * w.y; a0[5] += s1.y * w.x; a1[5] += s1.y * w.y; a0[6] += s1.z * w.x; a1[6] += s1.z * w.y; a0[7] += s1.w * w.x; a1[7] += s1.w * w.y;
              a0[8] += s2.x * w.x; a1[8] += s2.x * w.y;
          }
#pragma unroll
          for (int q = 0; q < 9; ++q) *(LAS f32x2*)(red + (wave * 9 + q) * 128 + 2 * lane) = (f32x2){a0[q], a1[q]};
          __syncthreads();
          for (int i = tid; i < 9 * 128; i += NTHR) { const int q = i >> 7, cc = i & 127; float s = 0.f;
#pragma unroll
              for (int w8 = 0; w8 < 8; ++w8) s += red[(w8 * 9 + q) * 128 + cc];
              const int col = cgp * 128 + cc; mod[((size_t)li * 9 + q) * 9216 + col] = s + p.b_ada[li * 9216 + col]; }
          __syncthreads();
      }
    }
    { LAS float* scr = (LAS float*)(lds + wave * 16384);
      for (int it = gw; it < C7; it += NGW) {
          const float* W; bf16* WT; int K, N, r; bool swi = false;
          if (it < C0) { const int mi = it / IT_FI; r = it % IT_FI; W = p.w_ffn_in + (size_t)mi * 1024 * 5632; WT = (bf16*)(p.ws + WS_FFNIN) + (size_t)mi * 5632 * 1024; K = 1024; N = 5632; swi = true; }
          else if (it < C1) { const int q = it - C0, mi = q / IT_FO; r = q % IT_FO; W = p.w_ffn_out + (size_t)mi * 2816 * 1024; WT = (bf16*)(p.ws + WS_FFNOUT) + (size_t)mi * 1024 * 2816; K = 2816; N = 1024; }
          else if (it < C2) { const int q = it - C1, mi = q / IT_QKV; r = q % IT_QKV; W = p.w_attn_qkv + (size_t)mi * 1024 * 1536; WT = (bf16*)(p.ws + WS_QKV) + (size_t)mi * 1536 * 1024; K = 1024; N = 1536; }
          else if (it < C3) { const int q = it - C2, mi = q / IT_SQ; r = q % IT_SQ; W = p.w_attn_o + (size_t)mi * 1024 * 1024; WT = (bf16*)(p.ws + WS_AO) + (size_t)mi * 1024 * 1024; K = 1024; N = 1024; }
          else if (it < C4) { r = it - C3; W = p.w_conv_in; WT = (bf16*)(p.ws + WS_CIN); K = 1024; N = 3072; }
          else if (it < C5) { r = it - C4; W = p.w_conv_out; WT = (bf16*)(p.ws + WS_COUT); K = 1024; N = 1024; }
          else if (it < C6) { r = it - C5; W = p.w_hgrn_in; WT = (bf16*)(p.ws + WS_HIN); K = 1024; N = 5120; }
          else { r = it - C6; W = p.w_hgrn_out; WT = (bf16*)(p.ws + WS_HOUT); K = 1024; N = 1024; }
          const int nblk = N / 32, kb = r / nblk, nb = r % nblk, n0 = 32 * nb;
          int drow0 = n0;
          if (swi) { drow0 = n0 < DFF ? (n0 / 128) * 256 + (n0 % 128) : ((n0 - DFF) / 128) * 256 + 128 + ((n0 - DFF) % 128); }
          p0_transpose_item(W, K, N, WT, 64 * kb, n0, drow0, scr, lane);
      }
    }
}

__device__ __forceinline__ void ew_phase(const Params& p, bool first, bool has_next, float res_scale,
                                         const float* modh, int gate_idx, const float* g_post, const float* modn, int sub_next, const float* g_pre) {
    const int tid = opaque_tid(), lane = tid & 63, wave = __builtin_amdgcn_readfirstlane(tid >> 6);
    const float* hbuf = (const float*)(p.ws + WS_H); bf16* hn = (bf16*)(p.ws + WS_HN);
    for (int m = blockIdx.x * 8 + wave; m < M; m += gridDim.x * 8) {
        const int cond = m < MP ? 0 : 1 + ((m - MP) >> 10);
        float* xo = p.out + (size_t)m * D;
        f32x4 x[4];
        if (first) { const f32x4* xi = (const f32x4*)(m < MP ? p.x_prompt + (size_t)m * D : p.x_sample + (size_t)(m - MP) * D) + lane;
#pragma unroll
            for (int j = 0; j < 4; ++j) x[j] = xi[64 * j];
        } else {
            const f32x4* xi = (const f32x4*)xo + lane; const f32x4* hi = (const f32x4*)(hbuf + (size_t)m * D) + lane;
            const f32x4* gt = (const f32x4*)(modh + (size_t)cond * 9216 + gate_idx * 1024) + lane; const f32x4* gp = (const f32x4*)g_post + lane;
            f32x4 h[4]; float ss = 0.f;
#pragma unroll
            for (int j = 0; j < 4; ++j) { h[j] = hi[64 * j]; x[j] = xi[64 * j]; ss += (h[j].x * h[j].x + h[j].y * h[j].y) + (h[j].z * h[j].z + h[j].w * h[j].w); }
            const float rs = res_scale * rsqrtf(wave_sum(ss) * (1.f / D) + EPS);
#pragma unroll
            for (int j = 0; j < 4; ++j) { const f32x4 g = gt[64 * j], q = gp[64 * j]; x[j] = x[j] + (h[j] * rs) * (g * q); }
        }
        { f32x4* xw = (f32x4*)xo + lane;
#pragma unroll
          for (int j = 0; j < 4; ++j) xw[64 * j] = x[j]; }
        if (has_next) {
            float ss = 0.f;
#pragma unroll
            for (int j = 0; j < 4; ++j) ss += (x[j].x * x[j].x + x[j].y * x[j].y) + (x[j].z * x[j].z + x[j].w * x[j].w);
            const float rs = rsqrtf(wave_sum(ss) * (1.f / D) + EPS);
            const f32x4* sh = (const f32x4*)(modn + (size_t)cond * 9216 + (3 * sub_next) * 1024) + lane; const f32x4* sc = (const f32x4*)(modn + (size_t)cond * 9216 + (3 * sub_next + 1) * 1024) + lane;
            const f32x4* gp = (const f32x4*)g_pre + lane;
            v2u* o8 = (v2u*)(hn + (size_t)m * D) + lane;
#pragma unroll
            for (int j = 0; j < 4; ++j) { const f32x4 g = gp[64 * j], s = sc[64 * j], t = sh[64 * j]; const f32x4 y = (x[j] * rs) * g * (s + 1.f) + t;
                v2u w; w.x = pk2(y.x, y.y); w.y = pk2(y.z, y.w); o8[64 * j] = w; }
        }
    }
}

__device__ __forceinline__ void conv_phase(const Params& p) {
    const int tid = opaque_tid(), lane = tid & 63, wave = __builtin_amdgcn_readfirstlane(tid >> 6);
    const bf16* z = (const bf16*)(p.ws + WS_Z); bf16* o = (bf16*)(p.ws + WS_O);
    for (int m = blockIdx.x * 8 + wave; m < M; m += gridDim.x * 8) {
        const int tpos = m < MP ? (m & 255) : ((m - MP) & 1023), L = m < MP ? 256 : 1024;
        const bool hp = tpos > 0, hx = tpos < L - 1;
        const bf16* zr = z + (size_t)m * 3072;
#pragma unroll
        for (int jj = 0; jj < 2; ++jj) {
            const int c0 = 8 * lane + 512 * jj;
            const v4u bg = *(const v4u*)(zr + c0), cg1 = *(const v4u*)(zr + 1024 + c0), u1 = *(const v4u*)(zr + 2048 + c0);
            v4u cg0 = (v4u){0u, 0u, 0u, 0u}, u0 = cg0, cg2 = cg0, u2 = cg0;
            if (hp) { cg0 = *(const v4u*)(zr - 3072 + 1024 + c0); u0 = *(const v4u*)(zr - 3072 + 2048 + c0); }
            if (hx) { cg2 = *(const v4u*)(zr + 3072 + 1024 + c0); u2 = *(const v4u*)(zr + 3072 + 2048 + c0); }
            const f32x4 w0a = *(const f32x4*)(p.conv_w + c0), w0b = *(const f32x4*)(p.conv_w + c0 + 4), w1a = *(const f32x4*)(p.conv_w + 1024 + c0), w1b = *(const f32x4*)(p.conv_w + 1024 + c0 + 4),
                        w2a = *(const f32x4*)(p.conv_w + 2048 + c0), w2b = *(const f32x4*)(p.conv_w + 2048 + c0 + 4), cba = *(const f32x4*)(p.conv_b + c0), cbb = *(const f32x4*)(p.conv_b + c0 + 4);
            float w0[8] = {w0a.x, w0a.y, w0a.z, w0a.w, w0b.x, w0b.y, w0b.z, w0b.w}, w1[8] = {w1a.x, w1a.y, w1a.z, w1a.w, w1b.x, w1b.y, w1b.z, w1b.w},
                  w2[8] = {w2a.x, w2a.y, w2a.z, w2a.w, w2b.x, w2b.y, w2b.z, w2b.w}, cb[8] = {cba.x, cba.y, cba.z, cba.w, cbb.x, cbb.y, cbb.z, cbb.w};
            float r[8];
#pragma unroll
            for (int e = 0; e < 4; ++e) {
                const float z0l = bflo(cg0[e]) * bflo(u0[e]), z0h = bfhi(cg0[e]) * bfhi(u0[e]), z1l = bflo(cg1[e]) * bflo(u1[e]), z1h = bfhi(cg1[e]) * bfhi(u1[e]),
                            z2l = bflo(cg2[e]) * bflo(u2[e]), z2h = bfhi(cg2[e]) * bfhi(u2[e]);
                r[2 * e] = bflo(bg[e]) * (cb[2 * e] + w0[2 * e] * z0l + w1[2 * e] * z1l + w2[2 * e] * z2l);
                r[2 * e + 1] = bfhi(bg[e]) * (cb[2 * e + 1] + w0[2 * e + 1] * z0h + w1[2 * e + 1] * z1h + w2[2 * e + 1] * z2h);
            }
            v4u w; w.x = pk2(r[0], r[1]); w.y = pk2(r[2], r[3]); w.z = pk2(r[4], r[5]); w.w = pk2(r[6], r[7]);
            *(v4u*)(o + (size_t)m * D + c0) = w;
        }
    }
}
__device__ __forceinline__ int crow(int r, int h) { return (r & 3) + 8 * (r >> 2) + 4 * h; }
__device__ __forceinline__ void attn_phase(const Params& p, LAS unsigned char* lds, int j) {
    const int tid = opaque_tid(), lane = tid & 63, wave = __builtin_amdgcn_readfirstlane(tid >> 6);
    const bf16* z = (const bf16*)(p.ws + WS_Z); bf16* o = (bf16*)(p.ws + WS_O);
    const bf16* ck = (const bf16*)(p.ws + WS_CK); const bf16* cv = (const bf16*)(p.ws + WS_CV);
    const float* cs = (const float*)(p.ws + WS_ROPE); const float* sn = cs + 1024 * 32;
    LAS bf16* Ks = (LAS bf16*)lds;
    LAS bf16* Vt = (LAS bf16*)(lds + 32 * 72 * 2);
    const int half = lane >> 5, n = lane & 31, g = wave >> 1, qs = wave & 1;
    for (int u = blockIdx.x; u < 768; u += gridDim.x) {
        const bool smp = u < 512;
        int b, kvh, qb, row0;
        if (smp) { b = u >> 6; kvh = (u >> 4) & 3; qb = u & 15; row0 = MP + b * 1024; }
        else { const int r = u - 512; b = r >> 4; kvh = (r >> 2) & 3; qb = r & 3; row0 = b * 256; }
        const int head = kvh * 4 + g, qpos = qb * 64 + qs * 32 + n;
        bf16x8 qf[4];
        { const bf16* qrow = z + (size_t)(row0 + qpos) * 1536 + head * 64 + 8 * half;
          float q[4][8];
#pragma unroll
          for (int ks = 0; ks < 4; ++ks) { const v4u r = *(const v4u*)(qrow + 16 * ks);
#pragma unroll
              for (int e = 0; e < 4; ++e) { q[ks][2 * e] = bflo(r[e]); q[ks][2 * e + 1] = bfhi(r[e]); } }
          if (smp) {
#pragma unroll
              for (int ks = 0; ks < 2; ++ks) { const float* cp = cs + qpos * 32 + 16 * ks + 8 * half; const float* sp = sn + qpos * 32 + 16 * ks + 8 * half;
                  const f32x4 c0 = *(const f32x4*)cp, c1 = *(const f32x4*)(cp + 4), s0 = *(const f32x4*)sp, s1 = *(const f32x4*)(sp + 4);
                  const float cc[8] = {c0.x, c0.y, c0.z, c0.w, c1.x, c1.y, c1.z, c1.w}, ss[8] = {s0.x, s0.y, s0.z, s0.w, s1.x, s1.y, s1.z, s1.w};
#pragma unroll
                  for (int e = 0; e < 8; ++e) { const float x1 = q[ks][e], x2 = q[ks + 2][e]; q[ks][e] = x1 * cc[e] - x2 * ss[e]; q[ks + 2][e] = x1 * ss[e] + x2 * cc[e]; } }
          }
          const float qsc = 0.125f * LOG2E;
#pragma unroll
          for (int ks = 0; ks < 4; ++ks) { v4u w;
#pragma unroll
              for (int e = 0; e < 4; ++e) w[e] = pk2(q[ks][2 * e] * qsc, q[ks][2 * e + 1] * qsc);
              qf[ks] = __builtin_bit_cast(bf16x8, w); }
        }
        float m_run = p.attn_sink[j * 16 + head] * LOG2E, l_run = 1.f;
        f32x16 O0, O1;
#pragma unroll
        for (int i = 0; i < 16; ++i) { O0[i] = 0.f; O1[i] = 0.f; }
        int lat_lo = 0, lat_n = 8;
        if (smp) { const int lo = max(0, qb * 64 - 128), hi = min(1024, qb * 64 + 192); lat_lo = lo; lat_n = (hi - lo) >> 5; }
        const int ntile = lat_n + (smp ? 8 : 0);
        for (int t = 0; t < ntile; ++t) {
            const bool is_lat = t < lat_n;
            const bf16 *kbase, *vbase; int pitch, kstart;
            if (is_lat) { kstart = lat_lo + 32 * t; kbase = z + (size_t)(row0 + kstart) * 1536 + 1024 + kvh * 64; vbase = kbase + 256; pitch = 1536; }
            else { kstart = 32 * (t - lat_n); kbase = ck + (size_t)((b * 2 + j) * 256 + kstart) * 256 + kvh * 64; vbase = cv + (size_t)((b * 2 + j) * 256 + kstart) * 256 + kvh * 64; pitch = 256; }
            __syncthreads();
            { const int key = tid >> 4, c = tid & 15;
              const bf16* kr = kbase + (size_t)key * pitch;
              unsigned lo = *(const unsigned*)(kr + 2 * c), hi = *(const unsigned*)(kr + 32 + 2 * c);
              if (smp && is_lat) { const int kp = kstart + key; const f32x2 c2 = *(const f32x2*)(cs + kp * 32 + 2 * c), s2 = *(const f32x2*)(sn + kp * 32 + 2 * c);
                  const float x1a = bflo(lo), x1b = bfhi(lo), x2a = bflo(hi), x2b = bfhi(hi);
                  lo = pk2(x1a * c2.x - x2a * s2.x, x1b * c2.y - x2b * s2.y); hi = pk2(x1a * s2.x + x2a * c2.x, x1b * s2.y + x2b * c2.y); }
              *(LAS unsigned*)(Ks + key * 72 + 2 * c) = lo; *(LAS unsigned*)(Ks + key * 72 + 32 + 2 * c) = hi;
              const v2u vv = *(const v2u*)(vbase + (size_t)key * pitch + 4 * c);
              Vt[(4 * c + 0) * 40 + key] = (bf16)(vv.x & 0xffffu); Vt[(4 * c + 1) * 40 + key] = (bf16)(vv.x >> 16);
              Vt[(4 * c + 2) * 40 + key] = (bf16)(vv.y & 0xffffu); Vt[(4 * c + 3) * 40 + key] = (bf16)(vv.y >> 16); }
            __syncthreads();
            f32x16 S;
#pragma unroll
            for (int i = 0; i < 16; ++i) S[i] = 0.f;
#pragma unroll
            for (int ks = 0; ks < 4; ++ks) { const bf16x8 a = *(const LAS bf16x8*)(Ks + n * 72 + 16 * ks + 8 * half); S = __builtin_amdgcn_mfma_f32_32x32x16_bf16(a, qf[ks], S, 0, 0, 0); }
            if (smp && is_lat) {
#pragma unroll
                for (int i = 0; i < 16; ++i) { const int dd = qpos - (kstart + crow(i, half)); if (dd > 128 || dd < -128) S[i] = -INFINITY; }
            }
            float mx = S[0];
#pragma unroll
            for (int i = 1; i < 16; ++i) mx = fmaxf(mx, S[i]);
            mx = fmaxf(mx, __shfl_xor(mx, 32));
            const float m_new = fmaxf(m_run, mx), alpha = __builtin_amdgcn_exp2f(m_run - m_new);
            float rs = 0.f;
#pragma unroll
            for (int i = 0; i < 16; ++i) { S[i] = __builtin_amdgcn_exp2f(S[i] - m_new); rs += S[i]; }
            rs += __shfl_xor(rs, 32);
            l_run = l_run * alpha + rs; m_run = m_new;
#pragma unroll
            for (int i = 0; i < 16; ++i) { O0[i] *= alpha; O1[i] *= alpha; }
            bf16x8 pb[2];
#pragma unroll
            for (int t2 = 0; t2 < 2; ++t2) { v4u w;
#pragma unroll
                for (int e = 0; e < 4; ++e) w[e] = pk2(S[8 * t2 + 2 * e], S[8 * t2 + 2 * e + 1]);
                pb[t2] = __builtin_bit_cast(bf16x8, w); }
#pragma unroll
            for (int t2 = 0; t2 < 2; ++t2) {
                { const LAS bf16* vp = Vt + n * 40 + 16 * t2 + 4 * half; const v2u lo = *(const LAS v2u*)vp, hi = *(const LAS v2u*)(vp + 8);
                  const v4u a = (v4u){lo.x, lo.y, hi.x, hi.y}; O0 = __builtin_amdgcn_mfma_f32_32x32x16_bf16(__builtin_bit_cast(bf16x8, a), pb[t2], O0, 0, 0, 0); }
                { const LAS bf16* vp = Vt + (32 + n) * 40 + 16 * t2 + 4 * half; const v2u lo = *(const LAS v2u*)vp, hi = *(const LAS v2u*)(vp + 8);
                  const v4u a = (v4u){lo.x, lo.y, hi.x, hi.y}; O1 = __builtin_amdgcn_mfma_f32_32x32x16_bf16(__builtin_bit_cast(bf16x8, a), pb[t2], O1, 0, 0, 0); }
            }
        }
        const float inv = 1.f / l_run;
        bf16* orow = o + (size_t)(row0 + qpos) * D + head * 64 + 4 * half;
#pragma unroll
        for (int gq = 0; gq < 4; ++gq) {
            v2u w0, w1; w0.x = pk2(O0[4 * gq] * inv, O0[4 * gq + 1] * inv); w0.y = pk2(O0[4 * gq + 2] * inv, O0[4 * gq + 3] * inv);
            w1.x = pk2(O1[4 * gq] * inv, O1[4 * gq + 1] * inv); w1.y = pk2(O1[4 * gq + 2] * inv, O1[4 * gq + 3] * inv);
            *(v2u*)(orow + 8 * gq) = w0; *(v2u*)(orow + 32 + 8 * gq) = w1;
        }
    }
}

__device__ __forceinline__ void scan_phase(const Params& p, LAS unsigned char* lds) {
    const int tid = opaque_tid(), lane = tid & 63, wave = __builtin_amdgcn_readfirstlane(tid >> 6);
    const bf16* z = (const bf16*)(p.ws + WS_Z);
    const float* lbt = (const float*)(p.ws + WS_LB);
    const int st = tid >> 5, c4 = (tid & 31) * 4, c2 = (tid & 31) * 2;
    for (int it = blockIdx.x; it < 768; it += gridDim.x) {
        const bool smp = it < 256; const int r = smp ? it : it - 256;
        const int half = r & 1, dir = (r >> 1) & 1, h = (r >> 2) & 7, b = r >> 5;
        const int L = smp ? 1024 : 256, row0 = smp ? MP + b * 1024 : b * 256;
        float* og = (float*)(p.ws + (dir ? WS_OB : WS_OF));
        float S[16];
        if (smp) { const float* s0 = p.state_hgrn + ((size_t)((b * 2 + dir) * 8 + h) * 128 + 16 * wave) * 128 + half * 64 + lane;
#pragma unroll
            for (int jj = 0; jj < 16; ++jj) S[jj] = s0[jj * 128];
        } else {
#pragma unroll
            for (int jj = 0; jj < 16; ++jj) S[jj] = 0.f;
        }
        const int colq = h * 128 + c4;
        const f32x4 lb4 = *(const f32x4*)(lbt + dir * 1024 + colq);
        const int nchunk = L >> 4;
        v2u rq, rf; unsigned rv;
#define SCAN_LOAD(c) do { const int tp_ = dir ? (L - 1 - ((c) * 16 + st)) : ((c) * 16 + st); const bf16* zr_ = z + (size_t)(row0 + tp_) * 5120; \
        rq = *(const v2u*)(zr_ + colq); rf = *(const v2u*)(zr_ + 2048 + dir * 1024 + colq); rv = *(const unsigned*)(zr_ + 1024 + h * 128 + half * 64 + c2); } while (0)
#define SCAN_STORE(bufi) do { LAS float* B_ = (LAS float*)(lds + (bufi) * 28672); \
        f32x4 q_, f_, k_; const float zq_[4] = {bflo(rq.x), bfhi(rq.x), bflo(rq.y), bfhi(rq.y)}, zf_[4] = {bflo(rf.x), bfhi(rf.x), bflo(rf.y), bfhi(rf.y)}; \
        _Pragma("unroll") for (int e_ = 0; e_ < 4; ++e_) { q_[e_] = silu_f(zq_[e_]) * 0.08838834764831845f; const float fv_ = lb4[e_] + (1.f - lb4[e_]) * sigmoid_f(zf_[e_]); f_[e_] = fv_; k_[e_] = 1.f - fv_; } \
        *(LAS f32x4*)(B_ + st * 128 + c4) = q_; *(LAS f32x4*)(B_ + 2048 + st * 128 + c4) = k_; *(LAS f32x4*)(B_ + 4096 + st * 128 + c4) = f_; \
        *(LAS f32x2*)(B_ + 6144 + st * 64 + c2) = (f32x2){bflo(rv), bfhi(rv)}; } while (0)
        SCAN_LOAD(0); SCAN_STORE(0);
        __syncthreads();
        for (int c = 0; c < nchunk; ++c) {
            const bool more = c + 1 < nchunk;
            if (more) SCAN_LOAD(c + 1);
            const LAS float* B = (const LAS float*)(lds + (c & 1) * 28672);
            LAS float* red = (LAS float*)(lds + 57344 + (c & 1) * 32768);
#pragma unroll
            for (int s2 = 0; s2 < 16; ++s2) {
                const float vv = B[6144 + s2 * 64 + lane];
                float acc = 0.f;
#pragma unroll
                for (int i4 = 0; i4 < 4; ++i4) {
                    const f32x4 q4 = *(const LAS f32x4*)(B + s2 * 128 + 16 * wave + 4 * i4), k4 = *(const LAS f32x4*)(B + 2048 + s2 * 128 + 16 * wave + 4 * i4), f4 = *(const LAS f32x4*)(B + 4096 + s2 * 128 + 16 * wave + 4 * i4);
#pragma unroll
                    for (int e = 0; e < 4; ++e) { const float sn_ = f4[e] * S[4 * i4 + e] + k4[e] * vv; S[4 * i4 + e] = sn_; acc += sn_ * q4[e]; }
                }
                red[(wave * 16 + s2) * 64 + lane] = acc;
            }
            if (more) SCAN_STORE((c + 1) & 1);
            __syncthreads();
            { float s0 = 0.f, s1 = 0.f;
#pragma unroll
              for (int w8 = 0; w8 < 8; ++w8) { const f32x2 t2 = *(const LAS f32x2*)(red + (w8 * 16 + st) * 64 + c2); s0 += t2.x; s1 += t2.y; }
              const int tp = dir ? (L - 1 - (c * 16 + st)) : (c * 16 + st);
              *(f32x2*)(og + (size_t)(row0 + tp) * D + h * 128 + half * 64 + c2) = (f32x2){s0, s1}; }
        }
#undef SCAN_LOAD
#undef SCAN_STORE
        if (!smp) { float* so = p.out + OUT_ST + ((size_t)((b * 2 + dir) * 8 + h) * 128 + 16 * wave) * 128 + half * 64 + lane;
#pragma unroll
            for (int jj = 0; jj < 16; ++jj) so[jj * 128] = S[jj]; }
        __syncthreads();
    }
}
__device__ __forceinline__ void hgate_phase(const Params& p) {
    const int tid = opaque_tid(), lane = tid & 63, wave = __builtin_amdgcn_readfirstlane(tid >> 6);
    const bf16* z = (const bf16*)(p.ws + WS_Z); bf16* o = (bf16*)(p.ws + WS_O);
    const float* of = (const float*)(p.ws + WS_OF); const float* ob = (const float*)(p.ws + WS_OB);
    for (int m = blockIdx.x * 8 + wave; m < M; m += gridDim.x * 8) {
        const f32x4* a = (const f32x4*)(of + (size_t)m * D + 16 * lane); const f32x4* bq = (const f32x4*)(ob + (size_t)m * D + 16 * lane);
        f32x4 v[4]; float ss = 0.f;
#pragma unroll
        for (int jj = 0; jj < 4; ++jj) { v[jj] = a[jj] + bq[jj]; ss += (v[jj].x * v[jj].x + v[jj].y * v[jj].y) + (v[jj].z * v[jj].z + v[jj].w * v[jj].w); }
        ss += __shfl_xor(ss, 1); ss += __shfl_xor(ss, 2); ss += __shfl_xor(ss, 4);
        const float rs = rsqrtf(ss * (1.f / 128.f) + EPS);
        const v4u g0 = *(const v4u*)(z + (size_t)m * 5120 + 4096 + 16 * lane), g1 = *(const v4u*)(z + (size_t)m * 5120 + 4096 + 16 * lane + 8);
        const f32x4* ng = (const f32x4*)(p.hgrn_norm_g + ((16 * lane) & 127));
        float r[16];
#pragma unroll
        for (int jj = 0; jj < 4; ++jj) { const f32x4 gg = ng[jj]; const unsigned ga = jj < 2 ? g0[2 * jj] : g1[2 * jj - 4], gb = jj < 2 ? g0[2 * jj + 1] : g1[2 * jj - 3];
            r[4 * jj] = v[jj].x * rs * gg.x * silu_f(bflo(ga)); r[4 * jj + 1] = v[jj].y * rs * gg.y * silu_f(bfhi(ga));
            r[4 * jj + 2] = v[jj].z * rs * gg.z * silu_f(bflo(gb)); r[4 * jj + 3] = v[jj].w * rs * gg.w * silu_f(bfhi(gb)); }
        v4u w0, w1; w0.x = pk2(r[0], r[1]); w0.y = pk2(r[2], r[3]); w0.z = pk2(r[4], r[5]); w0.w = pk2(r[6], r[7]);
        w1.x = pk2(r[8], r[9]); w1.y = pk2(r[10], r[11]); w1.z = pk2(r[12], r[13]); w1.w = pk2(r[14], r[15]);
        *(v4u*)(o + (size_t)m * D + 16 * lane) = w0; *(v4u*)(o + (size_t)m * D + 16 * lane + 8) = w1;
    }
}
constexpr int SC_QT = 0, SC_KT = 8704, SC_KH = 17408, SC_VT = 27648, SC_DD = 37888, SC_SEG = 38400, SC_QB = 42496;
__device__ __forceinline__ bf16x8 pack8(const f32x16& x, int s) {
    v4u w;
#pragma unroll
    for (int e = 0; e < 4; ++e) w[e] = pk2(x[8 * s + 2 * e], x[8 * s + 2 * e + 1]);
    return __builtin_bit_cast(bf16x8, w);
}
__device__ __forceinline__ bf16x8 ld2x64(const LAS bf16* p) { const v2u lo = *(const LAS v2u*)p, hi = *(const LAS v2u*)(p + 8); const v4u a = (v4u){lo.x, lo.y, hi.x, hi.y}; return __builtin_bit_cast(bf16x8, a); }

__device__ __forceinline__ void scan2_phase(const Params& p, LAS unsigned char* lds) {
    const int tid = opaque_tid(), lane = tid & 63, wave = __builtin_amdgcn_readfirstlane(tid >> 6);
    const bf16* z = (const bf16*)(p.ws + WS_Z);
    const float* lbt = (const float*)(p.ws + WS_LB);
    const int d0 = 2 * lane, seg = wave, half = lane >> 5, n = lane & 31;
    LAS bf16* QT = (LAS bf16*)(lds + SC_QT); LAS bf16* KT = (LAS bf16*)(lds + SC_KT); LAS bf16* KH = (LAS bf16*)(lds + SC_KH); LAS bf16* VT = (LAS bf16*)(lds + SC_VT);
    LAS bf16* QB = (LAS bf16*)(lds + SC_QB);
    LAS float* DD = (LAS float*)(lds + SC_DD); LAS float* SEG = (LAS float*)(lds + SC_SEG);
    for (int base = 0; base < 256; base += gridDim.x) {
        const int it = base + (int)blockIdx.x; if (it >= 256) break;
#pragma unroll 1
        for (int job = 0; job < 2; ++job) {
            int row0, L, h, dir, nq, qd0, bb;
            if (job == 0) { const int li0 = it >> 1; bb = li0 >> 4; h = (li0 >> 1) & 7; dir = li0 & 1; row0 = MP + bb * 1024; L = 1024; nq = 2; qd0 = 2 * (it & 1); }
            else { bb = it >> 4; h = (it >> 1) & 7; dir = it & 1; row0 = bb * 256; L = 256; nq = 4; qd0 = 0; }
            const int nround = L >> 5;
            const bool cw = wave < nq; const int qd = qd0 + wave;
            const f32x2 lb = *(const f32x2*)(lbt + dir * 1024 + h * 128 + d0);
            f32x16 S[4];
#pragma unroll
            for (int blk = 0; blk < 4; ++blk)
#pragma unroll
                for (int i = 0; i < 16; ++i) S[blk][i] = 0.f;
            if (cw && job == 0) { const float* s0 = p.state_hgrn + (size_t)((bb * 2 + dir) * 8 + h) * 16384 + 32 * qd + n;
#pragma unroll
                for (int blk = 0; blk < 4; ++blk)
#pragma unroll
                    for (int i = 0; i < 16; ++i) S[blk][i] = s0[(32 * blk + crow(i, half)) * 128]; }
            unsigned rq[4], rf[4], rv[4];
#define SC2_LOAD(r_) do { _Pragma("unroll") for (int i_ = 0; i_ < 4; ++i_) { const int tau_ = 32 * (r_) + 4 * seg + i_; const int tok_ = dir ? (L - 1 - tau_) : tau_; \
            const bf16* zr_ = z + (size_t)(row0 + tok_) * 5120 + h * 128 + d0; rq[i_] = *(const unsigned*)zr_; rv[i_] = *(const unsigned*)(zr_ + 1024); rf[i_] = *(const unsigned*)(zr_ + 2048 + dir * 1024); } } while (0)
            SC2_LOAD(0);
            for (int r = 0; r < nround; ++r) {
                float lf[4][2], kk[4][2], qq[4][2];
                { float c0 = 0.f, c1 = 0.f;
#pragma unroll
                  for (int i = 0; i < 4; ++i) {
                      const float f0 = lb.x + (1.f - lb.x) * sigmoid_f(bflo(rf[i])), f1 = lb.y + (1.f - lb.y) * sigmoid_f(bfhi(rf[i]));
                      c0 += __logf(f0); c1 += __logf(f1); lf[i][0] = c0; lf[i][1] = c1; kk[i][0] = 1.f - f0; kk[i][1] = 1.f - f1;
                      qq[i][0] = silu_f(bflo(rq[i])) * 0.08838834764831845f; qq[i][1] = silu_f(bfhi(rq[i])) * 0.08838834764831845f; }
                  *(LAS f32x2*)(SEG + seg * 128 + d0) = (f32x2){c0, c1};
                  v2u w0, w1; w0.x = (rv[0] & 0xffffu) | (rv[1] << 16); w0.y = (rv[2] & 0xffffu) | (rv[3] << 16); w1.x = (rv[0] >> 16) | (rv[1] & 0xffff0000u); w1.y = (rv[2] >> 16) | (rv[3] & 0xffff0000u);
                  *(LAS v2u*)(VT + d0 * 40 + 4 * seg) = w0; *(LAS v2u*)(VT + (d0 + 1) * 40 + 4 * seg) = w1; }
                if (r + 1 < nround) SC2_LOAD(r + 1);
                __syncthreads();
                { float off0 = 0.f, off1 = 0.f, br0 = 0.f, br1 = 0.f, bl0 = 0.f, bl1 = 0.f;
#pragma unroll
                  for (int s = 0; s < 8; ++s) { const f32x2 t2 = *(const LAS f32x2*)(SEG + s * 128 + d0); if (s < seg) { off0 += t2.x; off1 += t2.y; } if (s < 4) { br0 += t2.x; br1 += t2.y; } bl0 += t2.x; bl1 += t2.y; }
                  const float eh0 = __expf(bl0 - br0), eh1 = __expf(bl1 - br1), er0 = __expf(br0), er1 = __expf(br1);
                  float kh0[4], kh1[4];
#pragma unroll
                  for (int i = 0; i < 4; ++i) { const int t = 4 * seg + i;
                      const float eq0 = __expf(off0 + lf[i][0] - br0), eq1 = __expf(off1 + lf[i][1] - br1), ek0 = __builtin_amdgcn_rcpf(eq0), ek1 = __builtin_amdgcn_rcpf(eq1);
                      const float kt0 = kk[i][0] * ek0, kt1 = kk[i][1] * ek1;
                      *(LAS unsigned*)(QT + t * 136 + d0) = pk2(qq[i][0] * eq0, qq[i][1] * eq1); *(LAS unsigned*)(QB + t * 136 + d0) = pk2(qq[i][0] * eq0 * er0, qq[i][1] * eq1 * er1); *(LAS unsigned*)(KT + t * 136 + d0) = pk2(kt0, kt1);
                      kh0[i] = kt0 * eh0; kh1[i] = kt1 * eh1; }
                  v2u w0, w1; w0.x = pk2(kh0[0], kh0[1]); w0.y = pk2(kh0[2], kh0[3]); w1.x = pk2(kh1[0], kh1[1]); w1.y = pk2(kh1[2], kh1[3]);
                  *(LAS v2u*)(KH + d0 * 40 + 4 * seg) = w0; *(LAS v2u*)(KH + (d0 + 1) * 40 + 4 * seg) = w1;
                  if (seg == 7) *(LAS f32x2*)(DD + d0) = (f32x2){__expf(bl0), __expf(bl1)}; }
                __syncthreads();
                if (cw) {
                    f32x16 X;
#pragma unroll
                    for (int i = 0; i < 16; ++i) X[i] = 0.f;
#pragma unroll
                    for (int ks = 0; ks < 8; ++ks) { const bf16x8 a = *(const LAS bf16x8*)(KT + n * 136 + 16 * ks + 8 * half), bq = *(const LAS bf16x8*)(QT + n * 136 + 16 * ks + 8 * half);
                        X = __builtin_amdgcn_mfma_f32_32x32x16_bf16(a, bq, X, 0, 0, 0); }
#pragma unroll
                    for (int i = 0; i < 16; ++i) if (crow(i, half) > n) X[i] = 0.f;
                    f32x16 O;
#pragma unroll
                    for (int i = 0; i < 16; ++i) O[i] = 0.f;
#pragma unroll
                    for (int s2 = 0; s2 < 2; ++s2) O = __builtin_amdgcn_mfma_f32_32x32x16_bf16(ld2x64(VT + (32 * qd + n) * 40 + 16 * s2 + 4 * half), pack8(X, s2), O, 0, 0, 0);
#pragma unroll
                    for (int blk = 0; blk < 4; ++blk)
#pragma unroll
                        for (int s2 = 0; s2 < 2; ++s2) O = __builtin_amdgcn_mfma_f32_32x32x16_bf16(pack8(S[blk], s2), ld2x64(QB + n * 136 + 32 * blk + 16 * s2 + 4 * half), O, 0, 0, 0);
                    { const int tau = 32 * r + n, tok = dir ? (L - 1 - tau) : tau;
                      float* og = (float*)(p.ws + (dir ? WS_OB : WS_OF)) + (size_t)(row0 + tok) * D + h * 128 + 32 * qd + 4 * half;
#pragma unroll
                      for (int g = 0; g < 4; ++g) *(f32x4*)(og + 8 * g) = (f32x4){O[4 * g], O[4 * g + 1], O[4 * g + 2], O[4 * g + 3]}; }
#pragma unroll
                    for (int blk = 0; blk < 4; ++blk) {
#pragma unroll
                        for (int g = 0; g < 4; ++g) { const f32x4 dv4 = *(const LAS f32x4*)(DD + 32 * blk + 8 * g + 4 * half);
#pragma unroll
                            for (int e = 0; e < 4; ++e) S[blk][4 * g + e] *= dv4[e]; }
#pragma unroll
                        for (int k2 = 0; k2 < 2; ++k2) { const bf16x8 a = *(const LAS bf16x8*)(KH + (32 * blk + n) * 40 + 16 * k2 + 8 * half), bv = *(const LAS bf16x8*)(VT + (32 * qd + n) * 40 + 16 * k2 + 8 * half);
                            S[blk] = __builtin_amdgcn_mfma_f32_32x32x16_bf16(a, bv, S[blk], 0, 0, 0); }
                    }
                }
                __syncthreads();
            }
#undef SC2_LOAD
            if (cw && job == 1) { float* so = p.out + OUT_ST + (size_t)((bb * 2 + dir) * 8 + h) * 16384 + 32 * qd + n;
#pragma unroll
                for (int blk = 0; blk < 4; ++blk)
#pragma unroll
                    for (int i = 0; i < 16; ++i) so[(32 * blk + crow(i, half)) * 128] = S[blk][i]; }
        }
    }
}
#ifndef PROBE
#define PROBE 0
#endif
#if PROBE == 1
#define GSYNC() do { xcd_barrier(bar); xcd_barrier(bar); } while (0)
#else
#define GSYNC() xcd_barrier(bar)
#endif
__global__ void __launch_bounds__(NTHR, 2) fwd_megakernel(Params p) {
    extern __shared__ __attribute__((aligned(16))) unsigned char lds_raw[];
    cg::grid_group grid = cg::this_grid();
    LAS unsigned char* lds = (LAS unsigned char*)lds_raw;
    const int G = gridDim.x;
    { const int t0 = opaque_tid(); if (t0 < 64) ((LAS unsigned*)(lds + MISC_OFF))[t0] = 0u; }
    __syncthreads();
    const XcdBarrier bar = xcd_barrier_post((unsigned*)(p.ws + WS_CTL), (volatile LAS unsigned*)(lds + MISC_OFF) + 8);
    const float* mod = (const float*)(p.ws + WS_MOD);
    bf16* hn = (bf16*)(p.ws + WS_HN); bf16* zb = (bf16*)(p.ws + WS_Z); float* hb = (float*)(p.ws + WS_H); bf16* ob = (bf16*)(p.ws + WS_O);

    p0_prologue(p, lds);
#if PROBE == 2
    __syncthreads(); p0_prologue(p, lds);
#endif
    grid.sync();

#pragma unroll 1
    for (int li = 0; li < DEPTH; ++li) {
        const int kind = li % 3, jm = li / 3;
        const float* modl = mod + (size_t)li * 9 * 9216;
        const float* ng = p.norm_g + (size_t)li * 6 * 1024;
#pragma unroll 1
        for (int sub = 0; sub < 3; ++sub) {
            {
                const bool first = (li == 0 && sub == 0);
                const float* modh; const float* gpost; int gate_idx; float rscale;
                if (sub == 0) { modh = modl - 9 * 9216; gpost = ng - 6 * 1024 + 5 * 1024; gate_idx = 8; rscale = 0.5f; if (first) { modh = modl; gpost = ng; } }
                else if (sub == 1) { modh = modl; gpost = ng + 1 * 1024; gate_idx = 2; rscale = 0.5f; }
                else { modh = modl; gpost = ng + 3 * 1024; gate_idx = 5; rscale = 1.0f; }
                ew_phase(p, first, true, rscale, modh, gate_idx, gpost, modl, sub, ng + 2 * sub * 1024);
            }
            GSYNC();
            const bf16* A2; const bf16* B2; int K2;
            if (sub != 1) {
                const int wi = li * 2 + (sub >> 1);
                pg8::Gemm g{hn, (const bf16*)(p.ws + WS_FFNIN) + (size_t)wi * 5632 * 1024, M, 5632, 1024}; pg8::StaticOrder S; S.init(M, 5632, G, (int)blockIdx.x);
                EpiSwiGLU E{zb};
                pg8::gemm_phase<EpiSwiGLU, pg8::StaticOrder, true, true>(lds, g, S, E);
                GSYNC();
                A2 = zb; B2 = (const bf16*)(p.ws + WS_FFNOUT) + (size_t)wi * 1024 * 2816; K2 = 2816;
            } else {
                const bf16* Bi; int Ni; float* kout = nullptr; float* vout = nullptr;
                if (kind == 0) { Bi = (const bf16*)(p.ws + WS_QKV) + (size_t)jm * 1536 * 1024; Ni = 1536; kout = p.out + OUT_K + (size_t)jm * 65536; vout = p.out + OUT_V + (size_t)jm * 65536; B2 = (const bf16*)(p.ws + WS_AO) + (size_t)jm * 1024 * 1024; }
                else if (kind == 1) { Bi = (const bf16*)(p.ws + WS_CIN); Ni = 3072; B2 = (const bf16*)(p.ws + WS_COUT); }
                else { Bi = (const bf16*)(p.ws + WS_HIN); Ni = 5120; B2 = (const bf16*)(p.ws + WS_HOUT); }
                {
                    pg8::Gemm g{hn, Bi, M, Ni, 1024}; pg8::StaticOrder S; S.init(M, Ni, G, (int)blockIdx.x);
                    EpiZ E{zb, Ni, kout, vout};
                    pg8::gemm_phase<EpiZ, pg8::StaticOrder, true, true>(lds, g, S, E);
                }
                GSYNC();
                if (kind == 0) { attn_phase(p, lds, jm);
#if PROBE == 4
                    attn_phase(p, lds, jm);
#endif
                }
                else if (kind == 1) conv_phase(p);
                else { scan2_phase(p, lds);
#if PROBE == 3
                    scan2_phase(p, lds);
#endif
                    GSYNC(); hgate_phase(p); }
                GSYNC();
                A2 = ob; K2 = 1024;
            }
            {
                pg8::Gemm g{A2, B2, M, 1024, K2}; pg8::StaticOrder S; S.init(M, 1024, G, (int)blockIdx.x);
                EpiF32 E{hb};
                pg8::gemm_phase<EpiF32, pg8::StaticOrder, true, true>(lds, g, S, E);
            }
            GSYNC();
        }
    }
    ew_phase(p, false, false, 0.5f, mod + (size_t)3 * 9 * 9216, 8, p.norm_g + (size_t)(3 * 6 + 5) * 1024, mod, 0, p.norm_g);
}

extern "C" void kernel_launch(void* const* d_in, const int* in_sizes, int n_in, void* d_out, int out_size, void* d_ws, size_t ws_size, hipStream_t stream) {
    static int grid = 0;
    if (grid == 0) {
        if (n_in != 23 || ws_size < WS_END) { fprintf(stderr, "kernel_launch: expected 23 inputs and >= %zu bytes of workspace; got %d, %zu\n", (size_t)WS_END, n_in, ws_size); grid = -1; return; }
        int dev = 0, cus = 0, per_cu = 0;
        hipGetDevice(&dev); hipDeviceGetAttribute(&cus, hipDeviceAttributeMultiprocessorCount, dev);
        if (hipFuncSetAttribute((const void*)fwd_megakernel, hipFuncAttributeMaxDynamicSharedMemorySize, LDS_BYTES) != hipSuccess) { fprintf(stderr, "kernel_launch: hipFuncSetAttribute failed\n"); grid = -1; return; }
        if (hipOccupancyMaxActiveBlocksPerMultiprocessor(&per_cu, (const void*)fwd_megakernel, NTHR, LDS_BYTES) != hipSuccess || per_cu < 1) { fprintf(stderr, "kernel_launch: occupancy query gave %d\n", per_cu); per_cu = 1; }
        (void)hipGetLastError();
        grid = cus * per_cu;
    }
    if (grid < 0) return;
    if (hipMemsetAsync((char*)d_ws + WS_CTL, 0, CTL_BYTES, stream) != hipSuccess) { fprintf(stderr, "kernel_launch: hipMemsetAsync failed\n"); return; }
    Params p{};
    const float** pp = (const float**)&p;
    for (int i = 0; i < 23; ++i) pp[i] = (const float*)d_in[i];
    p.out = (float*)d_out; p.ws = (unsigned char*)d_ws;
    void* args[] = {&p};
    hipError_t e = hipLaunchCooperativeKernel((const void*)fwd_megakernel, dim3(grid), dim3(NTHR), args, LDS_BYTES, stream);
    if (e != hipSuccess) fprintf(stderr, "cooperative launch failed: %s (grid %d)\n", hipGetErrorString(e), grid);
}
```

```cpp
#define PROBE 0
#include <hip/hip_runtime.h>
#include <hip/hip_cooperative_groups.h>
#include <cstdio>
#include <cstdint>
namespace cg = cooperative_groups;
__device__ __forceinline__ int opaque_tid() { int t = threadIdx.x; asm volatile("" : "+v"(t)); return t; }
namespace pg8 {
#define PG8_LAS __attribute__((address_space(3)))
typedef unsigned short bf16_t;
typedef short bf16x8 __attribute__((ext_vector_type(8)));
typedef float f32x4 __attribute__((ext_vector_type(4)));
typedef unsigned u32x4 __attribute__((ext_vector_type(4)));
constexpr int BM = 256, BK = 64, HALF = 128, HTB = HALF * BK * 2  , STAGE_BYTES = 8 * HTB, NXCD = 8, WGM = 8;

__host__ __device__ __forceinline__ int lds_byte(int r, int c) { const int st = (r >> 4) * 2 + (c >> 5), rr = r & 15, cc = c & 31, ob = rr * 64 + cc * 2; return st * 1024 + (ob ^ (((ob >> 9) & 1) << 5)); }
__host__ __device__ __forceinline__ void stage_rc(int b, int& R, int& C) { const int st = b / 1024, sb = b % 1024, swz = sb ^ (((sb >> 9) & 1) << 5); R = (st >> 1) * 16 + swz / 64; C = (st & 1) * 32 + (swz % 64) / 2; }
__host__ __device__ __forceinline__ int perm32(int rho) { const int n = rho >> 4, i = rho & 15; return 8 * (i >> 2) + 4 * n + (i & 3); }

struct Unit { int pm, pn; };
struct Gemm { const bf16_t* A; const bf16_t* Bt; int M, N, K; };

struct StaticOrder {
    int nM, nN, nwg, G, c;
    __host__ __device__ void init(int M, int N, int G_, int c_) { nM = M / BM; nN = N / BM; nwg = nM * nN; G = G_; c = c_; }
    __host__ __device__ bool next(int i, Unit& u) const {
        const long L = (long)i * G + c; if (L >= nwg) return false;
        int wgid = (int)L; { const int q = nwg / NXCD, r = nwg % NXCD, xcd = wgid % NXCD, off = wgid / NXCD; wgid = (xcd < r ? xcd * (q + 1) : r * (q + 1) + (xcd - r) * q) + off; }
        const int nig = WGM * nN, gid = wgid / nig, fm = gid * WGM, gsz = (nM - fm) < WGM ? (nM - fm) : WGM;
        u.pm = fm + ((wgid % nig) % gsz); u.pn = (wgid % nig) / gsz; return true;
    }
    __device__ __forceinline__ void a_ready(const Unit&) const {}
    __device__ __forceinline__ void done(const Unit&) const {}
};

__device__ __forceinline__ unsigned cvt_pk_bf16(float lo, float hi) { unsigned r; asm volatile("v_cvt_pk_bf16_f32 %0, %1, %2" : "=v"(r) : "v"(lo), "v"(hi)); return r; }
typedef float f32x2 __attribute__((ext_vector_type(2)));
template <class Epi, class Sched, bool ALIGN_EPI = false, bool SP2 = false>
__device__ __forceinline__ void gemm_phase(PG8_LAS unsigned char* lds, const Gemm g, const Sched& S, const Epi& E) {
    const int tid = opaque_tid(), wid = __builtin_amdgcn_readfirstlane(tid >> 6), lane = tid & 63, wr = wid >> 2, wc = wid & 3, fr = lane & 15, fq = lane >> 4;
    const int K = g.K, nt = K / BK;
    unsigned voffA[2], voffB[2];
#pragma unroll
    for (int i = 0; i < 2; ++i) { int R, C; stage_rc(tid * 16 + i * 8192, R, C); const int Rb = Epi::PERM ? ((R & ~31) + perm32(R & 31)) : R;
        voffA[i] = (unsigned)(R * K + C) * 2u; voffB[i] = (unsigned)(Rb * K + C) * 2u; }
    const size_t kstep = (size_t)(BK * 2);
    const size_t hstep = (size_t)HALF * K * 2;
    const size_t tstep = 2 * hstep;
    const unsigned ldsw = (unsigned)wid * 1024u;
    const int aoff = lds_byte(wr * 64 + fr, fq * 8), boff = lds_byte(wc * 32 + fr, fq * 8);
#define PG8_SA(b, h) (((b) * 2 + (h)) * HTB)
#define PG8_SB(b, h) ((4 + (b) * 2 + (h)) * HTB)
#define PG8_STAGE(bufoff, gbase, voff) do { _Pragma("unroll") for (int _i = 0; _i < 2; ++_i) \
        __builtin_amdgcn_global_load_lds((const unsigned*)((const char*)(gbase) + (voff)[_i]), (PG8_LAS unsigned*)(lds + (bufoff) + ldsw + _i * 8192), 16, 0, 0); } while (0)
#define PG8_LDA(dst, b, h) do { _Pragma("unroll") for (int m = 0; m < 4; ++m) _Pragma("unroll") for (int k = 0; k < 2; ++k) dst[m][k] = *(const PG8_LAS bf16x8*)(lds + PG8_SA(b, h) + aoff + m * 2048 + k * 1024); } while (0)
#define PG8_LDB(dst, b, h) do { _Pragma("unroll") for (int n = 0; n < 2; ++n) _Pragma("unroll") for (int k = 0; k < 2; ++k) dst[n][k] = *(const PG8_LAS bf16x8*)(lds + PG8_SB(b, h) + boff + n * 2048 + k * 1024); } while (0)
#define PG8_MMA(ai, bj, At, Bt) do { __builtin_amdgcn_s_setprio(1); _Pragma("unroll") for (int m = 0; m < 4; ++m) _Pragma("unroll") for (int n = 0; n < 2; ++n) _Pragma("unroll") for (int k = 0; k < 2; ++k) \
        acc[ai][bj][m][n] = __builtin_amdgcn_mfma_f32_16x16x32_bf16(Bt[n][k], At[m][k], acc[ai][bj][m][n], 0, 0, 0); __builtin_amdgcn_s_setprio(0); } while (0)
#define PG8_WAIT_V(n) asm volatile("s_waitcnt vmcnt(" #n ")" ::: "memory")
#define PG8_WAIT_L(n) asm volatile("s_waitcnt lgkmcnt(" #n ")" ::: "memory")
#define PG8_BAR __builtin_amdgcn_s_barrier()
#define PG8_SCHED __builtin_amdgcn_sched_barrier(0)
    Unit cur, nxt; int ui = 0;
    if (!S.next(0, cur)) return;
    f32x4 acc[2][2][4][2];
#pragma unroll
    for (int a = 0; a < 2; ++a)
#pragma unroll
        for (int b = 0; b < 2; ++b)
#pragma unroll
            for (int m = 0; m < 4; ++m)
#pragma unroll
                for (int n = 0; n < 2; ++n) acc[a][b][m][n] = (f32x4){0.f, 0.f, 0.f, 0.f};
    bf16x8 At[4][2], B0[2][2], B1[2][2];
    const char* cA = (const char*)g.A + (size_t)cur.pm * tstep; const char* cB = (const char*)g.Bt + (size_t)cur.pn * tstep;
    S.a_ready(cur);
    if constexpr (SP2) {
        PG8_STAGE(PG8_SB(0, 0), cB, voffB); PG8_STAGE(PG8_SB(0, 1), cB + hstep, voffB); PG8_STAGE(PG8_SA(0, 0), cA, voffA); PG8_STAGE(PG8_SA(0, 1), cA + hstep, voffA);
        if (wr == 1) PG8_BAR;
        PG8_WAIT_V(2); PG8_BAR;
        PG8_STAGE(PG8_SB(1, 0), cB + kstep, voffB); PG8_STAGE(PG8_SA(1, 0), cA + kstep, voffA); PG8_STAGE(PG8_SB(1, 1), cB + hstep + kstep, voffB);
        PG8_WAIT_V(6); PG8_BAR;
    } else {
        PG8_STAGE(PG8_SB(0, 0), cB, voffB); PG8_STAGE(PG8_SA(0, 0), cA, voffA); PG8_STAGE(PG8_SB(0, 1), cB + hstep, voffB); PG8_STAGE(PG8_SA(0, 1), cA + hstep, voffA);
        if (wr == 1) PG8_BAR;
        PG8_WAIT_V(4); PG8_BAR;
        PG8_STAGE(PG8_SB(1, 0), cB + kstep, voffB); PG8_STAGE(PG8_SA(1, 0), cA + kstep, voffA); PG8_STAGE(PG8_SB(1, 1), cB + hstep + kstep, voffB);
        PG8_WAIT_V(6); PG8_BAR;
    }
    for (;;) {
        const bool has_next = S.next(ui + 1, nxt);
        const char* nA = has_next ? (const char*)g.A + (size_t)nxt.pm * tstep : cA; const char* nB = has_next ? (const char*)g.Bt + (size_t)nxt.pn * tstep : cB;
        for (int t = 0; t < nt; t += 2) {
            const bool last = (t == nt - 2);
            const char* a1 = cA + (size_t)(t + 1) * kstep;
            const char* a2 = last ? nA : cA + (size_t)(t + 2) * kstep; const char* b2 = last ? nB : cB + (size_t)(t + 2) * kstep;
            const char* a3 = a2 + kstep; const char* b3 = b2 + kstep;
            if (last && has_next) S.a_ready(nxt);
            if constexpr (SP2) {
            PG8_LDB(B0, 0, 0); PG8_LDB(B1, 0, 1); PG8_SCHED; PG8_LDA(At, 0, 0); PG8_STAGE(PG8_SA(1, 1), a1 + hstep, voffA);
            PG8_WAIT_V(8); PG8_WAIT_L(0); PG8_BAR; PG8_MMA(0, 0, At, B0); PG8_MMA(0, 1, At, B1); PG8_BAR; PG8_SCHED;
            PG8_LDA(At, 0, 1); PG8_STAGE(PG8_SB(0, 0), b2, voffB); PG8_STAGE(PG8_SB(0, 1), b2 + hstep, voffB); PG8_STAGE(PG8_SA(0, 0), a2, voffA);
            PG8_WAIT_V(8); PG8_WAIT_L(0); PG8_BAR; PG8_MMA(1, 0, At, B0); PG8_MMA(1, 1, At, B1); PG8_BAR; PG8_SCHED;
            PG8_LDB(B0, 1, 0); PG8_LDB(B1, 1, 1); PG8_SCHED; PG8_LDA(At, 1, 0); PG8_STAGE(PG8_SA(0, 1), a2 + hstep, voffA);
            PG8_WAIT_V(8); PG8_WAIT_L(0); PG8_BAR; PG8_MMA(0, 0, At, B0); PG8_MMA(0, 1, At, B1); PG8_BAR; PG8_SCHED;
            PG8_LDA(At, 1, 1); PG8_STAGE(PG8_SB(1, 0), b3, voffB); PG8_STAGE(PG8_SB(1, 1), b3 + hstep, voffB); PG8_STAGE(PG8_SA(1, 0), a3, voffA);
            PG8_WAIT_V(8); PG8_WAIT_L(0); PG8_BAR; PG8_MMA(1, 0, At, B0); PG8_MMA(1, 1, At, B1); PG8_BAR; PG8_SCHED;
            } else {
            PG8_LDB(B0, 0, 0); PG8_SCHED; PG8_LDA(At, 0, 0); PG8_STAGE(PG8_SA(1, 1), a1 + hstep, voffA);
            PG8_WAIT_L(8); PG8_BAR; PG8_WAIT_L(0); PG8_MMA(0, 0, At, B0); PG8_BAR; PG8_SCHED;
            PG8_LDB(B1, 0, 1); PG8_STAGE(PG8_SB(0, 0), b2, voffB);
            PG8_BAR; PG8_WAIT_L(0); PG8_MMA(0, 1, At, B1); PG8_BAR;
            PG8_LDA(At, 0, 1); PG8_STAGE(PG8_SA(0, 0), a2, voffA);
            PG8_BAR; PG8_WAIT_L(0); PG8_MMA(1, 0, At, B0); PG8_BAR; PG8_SCHED;
            PG8_STAGE(PG8_SB(0, 1), b2 + hstep, voffB);
            PG8_WAIT_V(6); PG8_BAR; PG8_MMA(1, 1, At, B1); PG8_BAR;
            PG8_LDB(B0, 1, 0); PG8_SCHED; PG8_LDA(At, 1, 0); PG8_STAGE(PG8_SA(0, 1), a2 + hstep, voffA);
            PG8_WAIT_L(8); PG8_BAR; PG8_WAIT_L(0); PG8_MMA(0, 0, At, B0); PG8_BAR; PG8_SCHED;
            PG8_LDB(B1, 1, 1); PG8_STAGE(PG8_SB(1, 0), b3, voffB);
            PG8_BAR; PG8_WAIT_L(0); PG8_MMA(0, 1, At, B1); PG8_BAR;
            PG8_LDA(At, 1, 1); PG8_STAGE(PG8_SA(1, 0), a3, voffA);
            PG8_BAR; PG8_WAIT_L(0); PG8_MMA(1, 0, At, B0); PG8_BAR; PG8_SCHED;
            PG8_STAGE(PG8_SB(1, 1), b3 + hstep, voffB);
            PG8_WAIT_V(6); PG8_BAR; PG8_MMA(1, 1, At, B1); PG8_BAR;
            }
        }
        if constexpr (ALIGN_EPI) { if (wr == 0) PG8_BAR; }
        if constexpr (!Epi::AFTER_DRAIN) { E(acc, cur, wr, wc, fr, fq); S.done(cur); }
        if (!has_next) break;
#pragma unroll
        for (int a = 0; a < 2; ++a)
#pragma unroll
            for (int b = 0; b < 2; ++b)
#pragma unroll
                for (int m = 0; m < 4; ++m)
#pragma unroll
                    for (int n = 0; n < 2; ++n) acc[a][b][m][n] = (f32x4){0.f, 0.f, 0.f, 0.f};
        cur = nxt; cA = nA; cB = nB; ++ui;
        if constexpr (ALIGN_EPI) { if (wr == 1) PG8_BAR; }
    }
    PG8_WAIT_V(0);
    if constexpr (!ALIGN_EPI) { if (wr == 0) PG8_BAR; }
    PG8_BAR;
    if constexpr (Epi::AFTER_DRAIN) { E.fused(acc, cur, wr, wc, fr, fq, lds, wid, lane); S.done(cur); }
#undef PG8_SA
#undef PG8_SB
#undef PG8_STAGE
#undef PG8_LDA
#undef PG8_LDB
#undef PG8_MMA
#undef PG8_WAIT_V
#undef PG8_WAIT_L
#undef PG8_BAR
#undef PG8_SCHED
}
}
#define LAS __attribute__((address_space(3)))
typedef unsigned short bf16;
typedef unsigned v4u __attribute__((ext_vector_type(4)));
typedef unsigned v2u __attribute__((ext_vector_type(2)));
typedef float f32x4 __attribute__((ext_vector_type(4)));
typedef float f32x2 __attribute__((ext_vector_type(2)));
typedef float f32x16 __attribute__((ext_vector_type(16)));
typedef short bf16x8 __attribute__((ext_vector_type(8)));

constexpr int NTHR = 512;
constexpr int D = 1024, MP = 4096, MS = 8192, M = MP + MS, DFF = 2816, DEPTH = 4;
constexpr int LDS_BYTES = 147456;
constexpr float EPS = 1e-6f;
constexpr float LOG2E = 1.4426950408889634f;

constexpr size_t MiB = 1u << 20;
constexpr size_t WS_FFNIN = 0;
constexpr size_t WS_FFNOUT = WS_FFNIN + 8ull * 5632 * 1024 * 2;
constexpr size_t WS_QKV = WS_FFNOUT + 8ull * 1024 * 2816 * 2;
constexpr size_t WS_AO = WS_QKV + 2ull * 1536 * 1024 * 2;
constexpr size_t WS_CIN = WS_AO + 2ull * 1024 * 1024 * 2;
constexpr size_t WS_COUT = WS_CIN + 3072ull * 1024 * 2;
constexpr size_t WS_HIN = WS_COUT + 1024ull * 1024 * 2;
constexpr size_t WS_HOUT = WS_HIN + 5120ull * 1024 * 2;
constexpr size_t WS_MOD = WS_HOUT + 1024ull * 1024 * 2;
constexpr size_t WS_ROPE = WS_MOD + 2 * MiB;
constexpr size_t WS_LB = WS_ROPE + MiB;
constexpr size_t WS_CK = WS_LB + MiB;
constexpr size_t WS_CV = WS_CK + 2 * MiB;
constexpr size_t WS_HN = WS_CV + 2 * MiB;
constexpr size_t WS_Z = WS_HN + 24 * MiB;
constexpr size_t WS_H = WS_Z + 120 * MiB;
constexpr size_t WS_O = WS_H + 48 * MiB;
constexpr size_t WS_OF = WS_O + 24 * MiB;
constexpr size_t WS_OB = WS_OF + 48 * MiB;
constexpr size_t WS_CTL = WS_OB + 48 * MiB, CTL_BYTES = 16384;
constexpr size_t WS_END = WS_CTL + MiB;
constexpr int MISC_OFF = 131072 + 320;

constexpr size_t OUT_YS = (size_t)MP * D, OUT_K = (size_t)M * D, OUT_V = OUT_K + 16ull * 2 * 256 * 256, OUT_ST = OUT_V + 16ull * 2 * 256 * 256;

struct Params {
    const float *x_prompt, *x_sample, *cache_k, *cache_v, *state_hgrn, *c, *c_ctx, *w_ada, *b_ada, *norm_g, *w_ffn_in, *w_ffn_out,
        *w_attn_qkv, *w_attn_o, *attn_sink, *w_conv_in, *conv_w, *conv_b, *w_conv_out, *w_hgrn_in, *hgrn_lb, *hgrn_norm_g, *w_hgrn_out;
    float* out; unsigned char* ws;
};

__device__ __forceinline__ unsigned f2bf(float f) { unsigned u = __builtin_bit_cast(unsigned, f); return (u + 0x7fffu + ((u >> 16) & 1u)) >> 16; }
typedef __bf16 bf16x2_t __attribute__((ext_vector_type(2)));
__device__ __forceinline__ unsigned pk2(float lo, float hi) { const f32x2 v = {lo, hi}; return __builtin_bit_cast(unsigned, __builtin_convertvector(v, bf16x2_t)); }
__device__ __forceinline__ float bflo(unsigned u) { return __uint_as_float(u << 16); }
__device__ __forceinline__ float bfhi(unsigned u) { return __uint_as_float(u & 0xffff0000u); }
__device__ __forceinline__ float sigmoid_f(float a) { return __builtin_amdgcn_rcpf(1.f + __expf(-a)); }
__device__ __forceinline__ float silu_f(float a) { return a * sigmoid_f(a); }
__device__ __forceinline__ float wave_sum(float v) {
#pragma unroll
    for (int o = 1; o < 64; o <<= 1) v += __shfl_xor(v, o);
    return v;
}
#define LDS_WAIT() asm volatile("s_waitcnt lgkmcnt(0)" ::: "memory")

struct EpiSwiGLU {
    static constexpr bool PERM = true, AFTER_DRAIN = false;
    bf16* O;
    __device__ __forceinline__ void operator()(const pg8::f32x4 (&acc)[2][2][4][2], const pg8::Unit& u, int wr, int wc, int fr, int fq) const {
        const int row0 = u.pm * 256 + wr * 64 + fr, col0 = u.pn * 128 + wc * 32 + 8 * fq;
#pragma unroll
        for (int ai = 0; ai < 2; ++ai)
#pragma unroll
            for (int m = 0; m < 4; ++m) {
                bf16* rowp = O + (size_t)(row0 + ai * 128 + m * 16) * DFF + col0;
                const pg8::f32x4 a0 = acc[ai][0][m][0], a1 = acc[ai][0][m][1], b0 = acc[ai][1][m][0], b1 = acc[ai][1][m][1];
                v4u w;
                w.x = pg8::cvt_pk_bf16(silu_f(a0[0]) * b0[0], silu_f(a0[1]) * b0[1]); w.y = pg8::cvt_pk_bf16(silu_f(a0[2]) * b0[2], silu_f(a0[3]) * b0[3]);
                w.z = pg8::cvt_pk_bf16(silu_f(a1[0]) * b1[0], silu_f(a1[1]) * b1[1]); w.w = pg8::cvt_pk_bf16(silu_f(a1[2]) * b1[2], silu_f(a1[3]) * b1[3]);
                *(v4u*)rowp = w;
            }
    }
};
struct EpiF32 {
    static constexpr bool PERM = false, AFTER_DRAIN = false;
    float* O;
    __device__ __forceinline__ void operator()(const pg8::f32x4 (&acc)[2][2][4][2], const pg8::Unit& u, int wr, int wc, int fr, int fq) const {
        const int row0 = u.pm * 256 + wr * 64 + fr, col0 = u.pn * 256 + wc * 32 + 4 * fq;
#pragma unroll
        for (int ai = 0; ai < 2; ++ai)
#pragma unroll
            for (int m = 0; m < 4; ++m) {
                float* rowp = O + (size_t)(row0 + ai * 128 + m * 16) * D + col0;
#pragma unroll
                for (int bj = 0; bj < 2; ++bj)
#pragma unroll
                    for (int n = 0; n < 2; ++n) *(pg8::f32x4*)(rowp + bj * 128 + n * 16) = acc[ai][bj][m][n];
            }
    }
};
struct EpiZ {
    static constexpr bool PERM = true, AFTER_DRAIN = false;
    bf16* O; int ldc; float* kout; float* vout;
    __device__ __forceinline__ void operator()(const pg8::f32x4 (&acc)[2][2][4][2], const pg8::Unit& u, int wr, int wc, int fr, int fq) const {
        const int row0 = u.pm * 256 + wr * 64 + fr, col0 = u.pn * 256 + wc * 32 + 8 * fq;
        const bool kv = (kout != nullptr) && u.pn >= 4 && u.pm < 16;
        float* kvb = (u.pn == 4) ? kout : vout;
#pragma unroll
        for (int ai = 0; ai < 2; ++ai)
#pragma unroll
            for (int m = 0; m < 4; ++m) {
                const int row = row0 + ai * 128 + m * 16;
                bf16* rowp = O + (size_t)row * ldc + col0;
#pragma unroll
                for (int bj = 0; bj < 2; ++bj) {
                    const pg8::f32x4 v0 = acc[ai][bj][m][0], v1 = acc[ai][bj][m][1];
                    v4u w; w.x = pg8::cvt_pk_bf16(v0[0], v0[1]); w.y = pg8::cvt_pk_bf16(v0[2], v0[3]); w.z = pg8::cvt_pk_bf16(v1[0], v1[1]); w.w = pg8::cvt_pk_bf16(v1[2], v1[3]);
                    *(v4u*)(rowp + bj * 128) = w;
                    if (kv) { float* dst = kvb + (size_t)(row >> 8) * (2 * 65536) + (size_t)(row & 255) * 256 + wc * 32 + 8 * fq + bj * 128;
                        *(pg8::f32x4*)dst = v0; *(pg8::f32x4*)(dst + 4) = v1; }
                }
            }
    }
};
#define XB_TMO      128
#define XB_XCNT(j)  (256  + 64 * (j))
#define XB_XSUB(j)  (1280 + 64 * (j))
#define XB_XGEN(j)  (2304 + 64 * (j))
#define XB_TOP      3328
#define XB_TOPGEN   3392
#define XCD_BAR_WORDS 3456
#define XB_SPIN_CAP (1u << 18)

__device__ __forceinline__ unsigned xb_ld(unsigned* p)              { return __hip_atomic_load(p, __ATOMIC_RELAXED, __HIP_MEMORY_SCOPE_AGENT); }
__device__ __forceinline__ unsigned xb_add(unsigned* p, unsigned v) { return __hip_atomic_fetch_add(p, v, __ATOMIC_RELAXED, __HIP_MEMORY_SCOPE_AGENT); }
__device__ __forceinline__ unsigned xb_xcc_id() { return (unsigned)__builtin_amdgcn_s_getreg((3 << 11) | 20) & 0xFu; }
#define XB_SPIN(cond, bar) do { unsigned _sp = 0; while (cond) { __builtin_amdgcn_s_sleep(1); \
    if ((++_sp & 255u) == 0u) { if (xb_ld(&(bar)[XB_TMO])) break; if (_sp > XB_SPIN_CAP) { atomicAdd(&(bar)[XB_TMO], 1u); break; } } } } while (0)

struct XcdBarrier {
    unsigned* bar; unsigned x;
    volatile LAS unsigned* st;
};

__device__ __forceinline__ XcdBarrier xcd_barrier_post(unsigned* bar, volatile LAS unsigned* st) {
    XcdBarrier b; b.bar = bar; b.x = xb_xcc_id(); b.st = st;
    if (threadIdx.x == 0) (void)xb_add(&bar[XB_XCNT(b.x)], 1u);
    return b;
}
__device__ __forceinline__ void xcd_barrier_complete(unsigned* bar, unsigned x, unsigned& nloc, unsigned& nx) {
    const unsigned G = gridDim.x * gridDim.y * gridDim.z;
    unsigned sum, cnt, mine, sp = 0u;
    for (;;) {
        sum = 0u; cnt = 0u; mine = 0u;
#pragma unroll
        for (unsigned j = 0; j < 16; ++j) { const unsigned c = xb_ld(&bar[XB_XCNT(j)]); sum += c; cnt += (c > 0u) ? 1u : 0u; mine = (j == x) ? c : mine; }
        if (sum == G) break;
        __builtin_amdgcn_s_sleep(1);
        if ((++sp & 255u) == 0u) { if (xb_ld(&bar[XB_TMO])) break; if (sp > XB_SPIN_CAP) { atomicAdd(&bar[XB_TMO], 1u); break; } }
    }
    nloc = mine > 0u ? mine : 1u; nx = cnt > 0u ? cnt : 1u;
}

__device__ __forceinline__ void xcd_barrier(const XcdBarrier& b) {
    asm volatile("s_waitcnt vmcnt(0)" ::: "memory");
    __syncthreads();
    if (threadIdx.x == 0) {
        unsigned* bar = b.bar;
        __builtin_amdgcn_s_waitcnt(0);
        unsigned nloc = b.st[0], nx = b.st[1];
        if (nloc == 0u) { xcd_barrier_complete(bar, b.x, nloc, nx); b.st[0] = nloc; b.st[1] = nx; }
        const unsigned old = xb_add(&bar[XB_XSUB(b.x)], 1u);
        const unsigned gen = old / nloc;
        if (old + 1u == (gen + 1u) * nloc) {
            __builtin_amdgcn_fence(__ATOMIC_RELEASE, "agent");
            asm volatile("s_waitcnt vmcnt(0)" ::: "memory");
            const unsigned og = xb_add(&bar[XB_TOP], 1u);
            const unsigned tg = og / nx;
            if (og + 1u == (tg + 1u) * nx) xb_add(&bar[XB_TOPGEN], 1u);
            else XB_SPIN(xb_ld(&bar[XB_TOPGEN]) == tg, bar);
            __builtin_amdgcn_fence(__ATOMIC_ACQUIRE, "agent");
            xb_add(&bar[XB_XGEN(b.x)], 1u);
            asm volatile("s_waitcnt vmcnt(0)" ::: "memory");
        } else {
            XB_SPIN(xb_ld(&bar[XB_XGEN(b.x)]) == gen, bar);
            __builtin_amdgcn_fence(__ATOMIC_ACQUIRE, "agent");
            asm volatile("s_waitcnt vmcnt(0)" ::: "memory");
        }
    }
    __syncthreads();
}
__device__ __forceinline__ void p0_transpose_item(const float* W, int K, int N, bf16* WT, int k0, int n0, int drow0, LAS float* scr, int lane) {
#pragma unroll 8
    for (int i = 0; i < 32; ++i) { const int kk = 2 * i + (lane >> 5); scr[kk * 33 + (lane & 31)] = W[(size_t)(k0 + kk) * N + n0 + (lane & 31)]; }
    LDS_WAIT(); asm volatile("" ::: "memory");
    const int c = lane & 7;
#pragma unroll
    for (int j = 0; j < 4; ++j) { const int n = (lane >> 3) + 8 * j; const LAS float* s = scr + (8 * c) * 33 + n;
        v4u o; o.x = pk2(s[0 * 33], s[1 * 33]); o.y = pk2(s[2 * 33], s[3 * 33]); o.z = pk2(s[4 * 33], s[5 * 33]); o.w = pk2(s[6 * 33], s[7 * 33]);
        *(v4u*)(WT + (size_t)(drow0 + n) * K + k0 + 8 * c) = o; }
    LDS_WAIT(); asm volatile("" ::: "memory");
}

constexpr int IT_FI = 16 * 176, IT_FO = 44 * 32, IT_QKV = 16 * 48, IT_SQ = 16 * 32, IT_CI = 16 * 96, IT_HI = 16 * 160;
constexpr int C0 = 8 * IT_FI, C1 = C0 + 8 * IT_FO, C2 = C1 + 2 * IT_QKV, C3 = C2 + 2 * IT_SQ, C4 = C3 + IT_CI, C5 = C4 + IT_SQ, C6 = C5 + IT_HI, C7 = C6 + IT_SQ;

__device__ __forceinline__ void p0_prologue(const Params& p, LAS unsigned char* lds) {
    const int tid = opaque_tid(), lane = tid & 63, wave = __builtin_amdgcn_readfirstlane(tid >> 6);
    const int gt = blockIdx.x * NTHR + tid, NGT = gridDim.x * NTHR;
    const int gw = blockIdx.x * 8 + wave, NGW = gridDim.x * 8;
    { float* cs = (float*)(p.ws + WS_ROPE); float* sn = cs + 1024 * 32;
      for (int i = gt; i < 1024 * 32; i += NGT) { const int t = i >> 5, k = i & 31; const float pos = (float)(k < 16 ? (t >> 6) : (t & 63));
          const float inv = exp2f(-(float)(k & 15) * (13.287712379549449f / 16.0f));
          const float ang = pos * inv; cs[i] = __cosf(ang); sn[i] = __sinf(ang); } }
    { float* lbt = (float*)(p.ws + WS_LB);
      for (int i = gt; i < 2048; i += NGT) { const int dir = i >> 10, d = i & 1023; const float* q = p.hgrn_lb + (size_t)dir * DEPTH * 1024 + d;
          const float a0 = q[0], a1 = q[1024], a2 = q[2048], a3 = q[3072]; const float mx = fmaxf(fmaxf(a0, a1), fmaxf(a2, a3));
          const float e0 = expf(a0 - mx), e1 = expf(a1 - mx), e2 = expf(a2 - mx), e3 = expf(a3 - mx);
          lbt[i] = (e1 + e2) / (e0 + e1 + e2 + e3); } }
    { bf16* ck = (bf16*)(p.ws + WS_CK); bf16* cv = (bf16*)(p.ws + WS_CV);
      for (int i = gt; i < 8 * 2 * 256 * 256 / 4; i += NGT) { const f32x4 a = ((const f32x4*)p.cache_k)[i], b = ((const f32x4*)p.cache_v)[i];
          v2u wa, wb; wa.x = pk2(a.x, a.y); wa.y = pk2(a.z, a.w); wb.x = pk2(b.x, b.y); wb.y = pk2(b.z, b.w);
          ((v2u*)ck)[i] = wa; ((v2u*)cv)[i] = wb; } }
    { LAS float* sc = (LAS float*)lds;
      LAS float* red = (LAS float*)(lds + 49152);
      for (int i = tid; i < 9 * 1024; i += NTHR) { const int cnd = i >> 10, k = i & 1023; const float v = cnd == 0 ? p.c_ctx[k] : p.c[(cnd - 1) * 1024 + k]; sc[k * 12 + cnd] = v / (1.f + expf(-v)); }
      __syncthreads();
      float* mod = (float*)(p.ws + WS_MOD);
      for (int task = blockIdx.x; task < 288; task += gridDim.x) {
          const int li = task / 72, cgp = task % 72;
          const float* W = p.w_ada + (size_t)li * 1024 * 9216 + cgp * 128 + 2 * lane;
          float a0[9], a1[9];
#pragma unroll
          for (int q = 0; q < 9; ++q) { a0[q] = 0.f; a1[q] = 0.f; }
          const int k0 = wave * 128;
#pragma unroll 8
          for (int k = k0; k < k0 + 128; ++k) {
              const f32x2 w = *(const f32x2*)(W + (size_t)k * 9216);
              const f32x4 s0 = *(const LAS f32x4*)(sc + k * 12), s1 = *(const LAS f32x4*)(sc + k * 12 + 4), s2 = *(const LAS f32x4*)(sc + k * 12 + 8);
              a0[0] += s0.x * w.x; a1[0] += s0.x * w.y; a0[1] += s0.y * w.x; a1[1] += s0.y * w.y; a0[2] += s0.z * w.x; a1[2] += s0.z * w.y; a0[3] += s0.w * w.x; a1[3] += s0.w * w.y;
              a0[4] += s1.x * w.x; a1[4] += s1.x * w.y; a0[5] += s1.y * w.x; a1[5] += s1.y * w.y; a0[6] += s1.z * w.x; a1[6] += s1.z * w.y; a0[7] += s1.w * w.x; a1[7] += s1.w * w.y;
              a0[8] += s2.x * w.x; a1[8] += s2.x * w.y;
          }
#pragma unroll
          for (int q = 0; q < 9; ++q) *(LAS f32x2*)(red + (wave * 9 + q) * 128 + 2 * lane) = (f32x2){a0[q], a1[q]};
          __syncthreads();
          for (int i = tid; i < 9 * 128; i += NTHR) { const int q = i >> 7, cc = i & 127; float s = 0.f;
#pragma unroll
              for (int w8 = 0; w8 < 8; ++w8) s += red[(w8 * 9 + q) * 128 + cc];
              const int col = cgp * 128 + cc; mod[((size_t)li * 9 + q) * 9216 + col] = s + p.b_ada[li * 9216 + col]; }
          __syncthreads();
      }
    }
    { LAS float* scr = (LAS float*)(lds + wave * 16384);
      for (int it = gw; it < C7; it += NGW) {
          const float* W; bf16* WT; int K, N, r; bool swi = false;
          if (it < C0) { const int mi = it / IT_FI; r = it % IT_FI; W = p.w_ffn_in + (size_t)mi * 1024 * 5632; WT = (bf16*)(p.ws + WS_FFNIN) + (size_t)mi * 5632 * 1024; K = 1024; N = 5632; swi = true; }
          else if (it < C1) { const int q = it - C0, mi = q / IT_FO; r = q % IT_FO; W = p.w_ffn_out + (size_t)mi * 2816 * 1024; WT = (bf16*)(p.ws + WS_FFNOUT) + (size_t)mi * 1024 * 2816; K = 2816; N = 1024; }
          else if (it < C2) { const int q = it - C1, mi = q / IT_QKV; r = q % IT_QKV; W = p.w_attn_qkv + (size_t)mi * 1024 * 1536; WT = (bf16*)(p.ws + WS_QKV) + (size_t)mi * 1536 * 1024; K = 1024; N = 1536; }
          else if (it < C3) { const int q = it - C2, mi = q / IT_SQ; r = q % IT_SQ; W = p.w_attn_o + (size_t)mi * 1024 * 1024; WT = (bf16*)(p.ws + WS_AO) + (size_t)mi * 1024 * 1024; K = 1024; N = 1024; }
          else if (it < C4) { r = it - C3; W = p.w_conv_in; WT = (bf16*)(p.ws + WS_CIN); K = 1024; N = 3072; }
          else if (it < C5) { r = it - C4; W = p.w_conv_out; WT = (bf16*)(p.ws + WS_COUT); K = 1024; N = 1024; }
          else if (it < C6) { r = it - C5; W = p.w_hgrn_in; WT = (bf16*)(p.ws + WS_HIN); K = 1024; N = 5120; }
          else { r = it - C6; W = p.w_hgrn_out; WT = (bf16*)(p.ws + WS_HOUT); K = 1024; N = 1024; }
          const int nblk = N / 32, kb = r / nblk, nb = r % nblk, n0 = 32 * nb;
          int drow0 = n0;
          if (swi) { drow0 = n0 < DFF ? (n0 / 128) * 256 + (n0 % 128) : ((n0 - DFF) / 128) * 256 + 128 + ((n0 - DFF) % 128); }
          p0_transpose_item(W, K, N, WT, 64 * kb, n0, drow0, scr, lane);
      }
    }
}

__device__ __forceinline__ void ew_phase(const Params& p, bool first, bool has_next, float res_scale,
                                         const float* modh, int gate_idx, const float* g_post, const float* modn, int sub_next, const float* g_pre) {
    const int tid = opaque_tid(), lane = tid & 63, wave = __builtin_amdgcn_readfirstlane(tid >> 6);
    const float* hbuf = (const float*)(p.ws + WS_H); bf16* hn = (bf16*)(p.ws + WS_HN);
    for (int m = blockIdx.x * 8 + wave; m < M; m += gridDim.x * 8) {
        const int cond = m < MP ? 0 : 1 + ((m - MP) >> 10);
        float* xo = p.out + (size_t)m * D;
        f32x4 x[4];
        if (first) { const f32x4* xi = (const f32x4*)(m < MP ? p.x_prompt + (size_t)m * D : p.x_sample + (size_t)(m - MP) * D) + lane;
#pragma unroll
            for (int j = 0; j < 4; ++j) x[j] = xi[64 * j];
        } else {
            const f32x4* xi = (const f32x4*)xo + lane; const f32x4* hi = (const f32x4*)(hbuf + (size_t)m * D) + lane;
            const f32x4* gt = (const f32x4*)(modh + (size_t)cond * 9216 + gate_idx * 1024) + lane; const f32x4* gp = (const f32x4*)g_post + lane;
            f32x4 h[4]; float ss = 0.f;
#pragma unroll
            for (int j = 0; j < 4; ++j) { h[j] = hi[64 * j]; x[j] = xi[64 * j]; ss += (h[j].x * h[j].x + h[j].y * h[j].y) + (h[j].z * h[j].z + h[j].w * h[j].w); }
            const float rs = res_scale * rsqrtf(wave_sum(ss) * (1.f / D) + EPS);
#pragma unroll
            for (int j = 0; j < 4; ++j) { const f32x4 g = gt[64 * j], q = gp[64 * j]; x[j] = x[j] + (h[j] * rs) * (g * q); }
        }
        { f32x4* xw = (f32x4*)xo + lane;
#pragma unroll
          for (int j = 0; j < 4; ++j) xw[64 * j] = x[j]; }
        if (has_next) {
            float ss = 0.f;
#pragma unroll
            for (int j = 0; j < 4; ++j) ss += (x[j].x * x[j].x + x[j].y * x[j].y) + (x[j].z * x[j].z + x[j].w * x[j].w);
            const float rs = rsqrtf(wave_sum(ss) * (1.f / D) + EPS);
            const f32x4* sh = (const f32x4*)(modn + (size_t)cond * 9216 + (3 * sub_next) * 1024) + lane; const f32x4* sc = (const f32x4*)(modn + (size_t)cond * 9216 + (3 * sub_next + 1) * 1024) + lane;
            const f32x4* gp = (const f32x4*)g_pre + lane;
            v2u* o8 = (v2u*)(hn + (size_t)m * D) + lane;
#pragma unroll
            for (int j = 0; j < 4; ++j) { const f32x4 g = gp[64 * j], s = sc[64 * j], t = sh[64 * j]; const f32x4 y = (x[j] * rs) * g * (s + 1.f) + t;
                v2u w; w.x = pk2(y.x, y.y); w.y = pk2(y.z, y.w); o8[64 * j] = w; }
        }
    }
}

__device__ __forceinline__ void conv_phase(const Params& p) {
    const int tid = opaque_tid(), lane = tid & 63, wave = __builtin_amdgcn_readfirstlane(tid >> 6);
    const bf16* z = (const bf16*)(p.ws + WS_Z); bf16* o = (bf16*)(p.ws + WS_O);
    for (int m = blockIdx.x * 8 + wave; m < M; m += gridDim.x * 8) {
        const int tpos = m < MP ? (m & 255) : ((m - MP) & 1023), L = m < MP ? 256 : 1024;
        const bool hp = tpos > 0, hx = tpos < L - 1;
        const bf16* zr = z + (size_t)m * 3072;
#pragma unroll
        for (int jj = 0; jj < 2; ++jj) {
            const int c0 = 8 * lane + 512 * jj;
            const v4u bg = *(const v4u*)(zr + c0), cg1 = *(const v4u*)(zr + 1024 + c0), u1 = *(const v4u*)(zr + 2048 + c0);
            v4u cg0 = (v4u){0u, 0u, 0u, 0u}, u0 = cg0, cg2 = cg0, u2 = cg0;
            if (hp) { cg0 = *(const v4u*)(zr - 3072 + 1024 + c0); u0 = *(const v4u*)(zr - 3072 + 2048 + c0); }
            if (hx) { cg2 = *(const v4u*)(zr + 3072 + 1024 + c0); u2 = *(const v4u*)(zr + 3072 + 2048 + c0); }
            const f32x4 w0a = *(const f32x4*)(p.conv_w + c0), w0b = *(const f32x4*)(p.conv_w + c0 + 4), w1a = *(const f32x4*)(p.conv_w + 1024 + c0), w1b = *(const f32x4*)(p.conv_w + 1024 + c0 + 4),
                        w2a = *(const f32x4*)(p.conv_w + 2048 + c0), w2b = *(const f32x4*)(p.conv_w + 2048 + c0 + 4), cba = *(const f32x4*)(p.conv_b + c0), cbb = *(const f32x4*)(p.conv_b + c0 + 4);
            float w0[8] = {w0a.x, w0a.y, w0a.z, w0a.w, w0b.x, w0b.y, w0b.z, w0b.w}, w1[8] = {w1a.x, w1a.y, w1a.z, w1a.w, w1b.x, w1b.y, w1b.z, w1b.w},
                  w2[8] = {w2a.x, w2a.y, w2a.z, w2a.w, w2b.x, w2b.y, w2b.z, w2b.w}, cb[8] = {cba.x, cba.y, cba.z, cba.w, cbb.x, cbb.y, cbb.z, cbb.w};
            float r[8];
#pragma unroll
            for (int e = 0; e < 4; ++e) {
                const float z0l = bflo(cg0[e]) * bflo(u0[e]), z0h = bfhi(cg0[e]) * bfhi(u0[e]), z1l = bflo(cg1[e]) * bflo(u1[e]), z1h = bfhi(cg1[e]) * bfhi(u1[e]),
                            z2l = bflo(cg2[e]) * bflo(u2[e]), z2h = bfhi(cg2[e]) * bfhi(u2[e]);
                r[2 * e] = bflo(bg[e]) * (cb[2 * e] + w0[2 * e] * z0l + w1[2 * e] * z1l + w2[2 * e] * z2l);
                r[2 * e + 1] = bfhi(bg[e]) * (cb[2 * e + 1] + w0[2 * e + 1] * z0h + w1[2 * e + 1] * z1h + w2[2 * e + 1] * z2h);
            }
            v4u w; w.x = pk2(r[0], r[1]); w.y = pk2(r[2], r[3]); w.z = pk2(r[4], r[5]); w.w = pk2(r[6], r[7]);
            *(v4u*)(o + (size_t)m * D + c0) = w;
        }
    }
}
__device__ __forceinline__ int crow(int r, int h) { return (r & 3) + 8 * (r >> 2) + 4 * h; }
constexpr int AT_BUF = 18432;
__device__ __forceinline__ void attn_phase(const Params& p, LAS unsigned char* lds, int j) {
    const int tid = opaque_tid(), lane = tid & 63, wave = __builtin_amdgcn_readfirstlane(tid >> 6);
    const bf16* z = (const bf16*)(p.ws + WS_Z); bf16* o = (bf16*)(p.ws + WS_O);
    const bf16* ck = (const bf16*)(p.ws + WS_CK); const bf16* cv = (const bf16*)(p.ws + WS_CV);
    const float* cs = (const float*)(p.ws + WS_ROPE); const float* sn = cs + 1024 * 32;
    const int half = lane >> 5, n = lane & 31, g = wave >> 1, qs = wave & 1;
    const int skey = tid >> 3, sc = tid & 7;
    for (int u = blockIdx.x; u < 768; u += gridDim.x) {
        const bool smp = u < 512;
        int b, kvh, qb, row0;
        if (smp) { b = u >> 6; kvh = (u >> 4) & 3; qb = u & 15; row0 = MP + b * 1024; }
        else { const int r = u - 512; b = r >> 4; kvh = (r >> 2) & 3; qb = r & 3; row0 = b * 256; }
        const int head = kvh * 4 + g, qpos = qb * 64 + qs * 32 + n;
        bf16x8 qf[4];
        { const bf16* qrow = z + (size_t)(row0 + qpos) * 1536 + head * 64 + 8 * half;
          float q[4][8];
#pragma unroll
          for (int ks = 0; ks < 4; ++ks) { const v4u r = *(const v4u*)(qrow + 16 * ks);
#pragma unroll
              for (int e = 0; e < 4; ++e) { q[ks][2 * e] = bflo(r[e]); q[ks][2 * e + 1] = bfhi(r[e]); } }
          if (smp) {
#pragma unroll
              for (int ks = 0; ks < 2; ++ks) { const float* cp = cs + qpos * 32 + 16 * ks + 8 * half; const float* sp = sn + qpos * 32 + 16 * ks + 8 * half;
                  const f32x4 c0 = *(const f32x4*)cp, c1 = *(const f32x4*)(cp + 4), s0 = *(const f32x4*)sp, s1 = *(const f32x4*)(sp + 4);
                  const float cc[8] = {c0.x, c0.y, c0.z, c0.w, c1.x, c1.y, c1.z, c1.w}, ss[8] = {s0.x, s0.y, s0.z, s0.w, s1.x, s1.y, s1.z, s1.w};
#pragma unroll
                  for (int e = 0; e < 8; ++e) { const float x1 = q[ks][e], x2 = q[ks + 2][e]; q[ks][e] = x1 * cc[e] - x2 * ss[e]; q[ks + 2][e] = x1 * ss[e] + x2 * cc[e]; } }
          }
          const float qsc = 0.125f * LOG2E;
#pragma unroll
          for (int ks = 0; ks < 4; ++ks) { v4u w;
#pragma unroll
              for (int e = 0; e < 4; ++e) w[e] = pk2(q[ks][2 * e] * qsc, q[ks][2 * e + 1] * qsc);
              qf[ks] = __builtin_bit_cast(bf16x8, w); }
        }
        float m_run = p.attn_sink[j * 16 + head] * LOG2E, l_run = 1.f;
        f32x16 O0, O1;
#pragma unroll
        for (int i = 0; i < 16; ++i) { O0[i] = 0.f; O1[i] = 0.f; }
        int lat_lo = 0, lat_n = 4;
        if (smp) { const int lo = max(0, qb * 64 - 128), hi = min(1024, qb * 64 + 192); lat_lo = lo; lat_n = (hi - lo) >> 6; }
        const int ntile = lat_n + (smp ? 4 : 0);
        v2u pk_lo, pk_hi; v4u pv; f32x4 pc, ps;
#define AT_LOAD(T_) do { const int t_ = (T_); const bool il_ = t_ < lat_n; const bf16 *kb_, *vb_; \
            if (il_) { const int ks_ = lat_lo + 64 * t_ + skey; kb_ = z + (size_t)(row0 + ks_) * 1536 + 1024 + kvh * 64; vb_ = kb_ + 256; \
                if (smp) { pc = *(const f32x4*)(cs + ks_ * 32 + 4 * sc); ps = *(const f32x4*)(sn + ks_ * 32 + 4 * sc); } } \
            else { const int ks_ = 64 * (t_ - lat_n) + skey; kb_ = ck + (size_t)((b * 2 + j) * 256 + ks_) * 256 + kvh * 64; vb_ = cv + (size_t)((b * 2 + j) * 256 + ks_) * 256 + kvh * 64; } \
            pk_lo = *(const v2u*)(kb_ + 4 * sc); pk_hi = *(const v2u*)(kb_ + 32 + 4 * sc); pv = *(const v4u*)(vb_ + 8 * sc); } while (0)
#define AT_STORE(T_) do { const int t_ = (T_); LAS bf16* Ks_ = (LAS bf16*)(lds + (t_ & 1) * AT_BUF); LAS bf16* Vt_ = Ks_ + 64 * 72; v2u lo_ = pk_lo, hi_ = pk_hi; \
            if (smp && t_ < lat_n) { const float a0 = bflo(lo_.x), a1 = bfhi(lo_.x), a2 = bflo(lo_.y), a3 = bfhi(lo_.y), b0 = bflo(hi_.x), b1 = bfhi(hi_.x), b2 = bflo(hi_.y), b3 = bfhi(hi_.y); \
                lo_.x = pk2(a0 * pc.x - b0 * ps.x, a1 * pc.y - b1 * ps.y); lo_.y = pk2(a2 * pc.z - b2 * ps.z, a3 * pc.w - b3 * ps.w); \
                hi_.x = pk2(a0 * ps.x + b0 * pc.x, a1 * ps.y + b1 * pc.y); hi_.y = pk2(a2 * ps.z + b2 * pc.z, a3 * ps.w + b3 * pc.w); } \
            *(LAS v2u*)(Ks_ + skey * 72 + 4 * sc) = lo_; *(LAS v2u*)(Ks_ + skey * 72 + 32 + 4 * sc) = hi_; \
            _Pragma("unroll") for (int e_ = 0; e_ < 4; ++e_) { Vt_[(8 * sc + 2 * e_) * 72 + skey] = (bf16)(pv[e_] & 0xffffu); Vt_[(8 * sc + 2 * e_ + 1) * 72 + skey] = (bf16)(pv[e_] >> 16); } } while (0)
        __syncthreads();
        AT_LOAD(0); AT_STORE(0);
        if (ntile > 1) AT_LOAD(1);
        __syncthreads();
        for (int t = 0; t < ntile; ++t) {
            if (t + 1 < ntile) AT_STORE(t + 1);
            if (t + 2 < ntile) AT_LOAD(t + 2);
            const LAS bf16* Ks = (const LAS bf16*)(lds + (t & 1) * AT_BUF); const LAS bf16* Vt = Ks + 64 * 72;
            const bool is_lat = t < lat_n;
            const int kstart0 = is_lat ? lat_lo + 64 * t : 0;
#pragma unroll
            for (int sub = 0; sub < 2; ++sub) {
                f32x16 S;
#pragma unroll
                for (int i = 0; i < 16; ++i) S[i] = 0.f;
#pragma unroll
                for (int ks = 0; ks < 4; ++ks) { const bf16x8 a = *(const LAS bf16x8*)(Ks + (32 * sub + n) * 72 + 16 * ks + 8 * half); S = __builtin_amdgcn_mfma_f32_32x32x16_bf16(a, qf[ks], S, 0, 0, 0); }
                if (smp && is_lat) { const int kstart = kstart0 + 32 * sub;
#pragma unroll
                    for (int i = 0; i < 16; ++i) { const int dd = qpos - (kstart + crow(i, half)); if (dd > 128 || dd < -128) S[i] = -INFINITY; }
                }
                float mx = S[0];
#pragma unroll
                for (int i = 1; i < 16; ++i) mx = fmaxf(mx, S[i]);
                mx = fmaxf(mx, __shfl_xor(mx, 32));
                const float m_new = fmaxf(m_run, mx), alpha = __builtin_amdgcn_exp2f(m_run - m_new);
                float rs = 0.f;
#pragma unroll
                for (int i = 0; i < 16; ++i) { S[i] = __builtin_amdgcn_exp2f(S[i] - m_new); rs += S[i]; }
                rs += __shfl_xor(rs, 32);
                l_run = l_run * alpha + rs; m_run = m_new;
#pragma unroll
                for (int i = 0; i < 16; ++i) { O0[i] *= alpha; O1[i] *= alpha; }
                bf16x8 pb[2];
#pragma unroll
                for (int t2 = 0; t2 < 2; ++t2) { v4u w;
#pragma unroll
                    for (int e = 0; e < 4; ++e) w[e] = pk2(S[8 * t2 + 2 * e], S[8 * t2 + 2 * e + 1]);
                    pb[t2] = __builtin_bit_cast(bf16x8, w); }
#pragma unroll
                for (int t2 = 0; t2 < 2; ++t2) {
                    { const LAS bf16* vp = Vt + n * 72 + 32 * sub + 16 * t2 + 4 * half; const v2u lo = *(const LAS v2u*)vp, hi = *(const LAS v2u*)(vp + 8);
                      const v4u a = (v4u){lo.x, lo.y, hi.x, hi.y}; O0 = __builtin_amdgcn_mfma_f32_32x32x16_bf16(__builtin_bit_cast(bf16x8, a), pb[t2], O0, 0, 0, 0); }
                    { const LAS bf16* vp = Vt + (32 + n) * 72 + 32 * sub + 16 * t2 + 4 * half; const v2u lo = *(const LAS v2u*)vp, hi = *(const LAS v2u*)(vp + 8);
                      const v4u a = (v4u){lo.x, lo.y, hi.x, hi.y}; O1 = __builtin_amdgcn_mfma_f32_32x32x16_bf16(__builtin_bit_cast(bf16x8, a), pb[t2], O1, 0, 0, 0); }
                }
            }
            __syncthreads();
        }
#undef AT_LOAD
#undef AT_STORE
        const float inv = 1.f / l_run;
        bf16* orow = o + (size_t)(row0 + qpos) * D + head * 64 + 4 * half;
#pragma unroll
        for (int gq = 0; gq < 4; ++gq) {
            v2u w0, w1; w0.x = pk2(O0[4 * gq] * inv, O0[4 * gq + 1] * inv); w0.y = pk2(O0[4 * gq + 2] * inv, O0[4 * gq + 3] * inv);
            w1.x = pk2(O1[4 * gq] * inv, O1[4 * gq + 1] * inv); w1.y = pk2(O1[4 * gq + 2] * inv, O1[4 * gq + 3] * inv);
            *(v2u*)(orow + 8 * gq) = w0; *(v2u*)(orow + 32 + 8 * gq) = w1;
        }
    }
}

__device__ __forceinline__ void scan_phase(const Params& p, LAS unsigned char* lds) {
    const int tid = opaque_tid(), lane = tid & 63, wave = __builtin_amdgcn_readfirstlane(tid >> 6);
    const bf16* z = (const bf16*)(p.ws + WS_Z);
    const float* lbt = (const float*)(p.ws + WS_LB);
    const int st = tid >> 5, c4 = (tid & 31) * 4, c2 = (tid & 31) * 2;
    for (int it = blockIdx.x; it < 768; it += gridDim.x) {
        const bool smp = it < 256; const int r = smp ? it : it - 256;
        const int half = r & 1, dir = (r >> 1) & 1, h = (r >> 2) & 7, b = r >> 5;
        const int L = smp ? 1024 : 256, row0 = smp ? MP + b * 1024 : b * 256;
        float* og = (float*)(p.ws + (dir ? WS_OB : WS_OF));
        float S[16];
        if (smp) { const float* s0 = p.state_hgrn + ((size_t)((b * 2 + dir) * 8 + h) * 128 + 16 * wave) * 128 + half * 64 + lane;
#pragma unroll
            for (int jj = 0; jj < 16; ++jj) S[jj] = s0[jj * 128];
        } else {
#pragma unroll
            for (int jj = 0; jj < 16; ++jj) S[jj] = 0.f;
        }
        const int colq = h * 128 + c4;
        const f32x4 lb4 = *(const f32x4*)(lbt + dir * 1024 + colq);
        const int nchunk = L >> 4;
        v2u rq, rf; unsigned rv;
#define SCAN_LOAD(c) do { const int tp_ = dir ? (L - 1 - ((c) * 16 + st)) : ((c) * 16 + st); const bf16* zr_ = z + (size_t)(row0 + tp_) * 5120; \
        rq = *(const v2u*)(zr_ + colq); rf = *(const v2u*)(zr_ + 2048 + dir * 1024 + colq); rv = *(const unsigned*)(zr_ + 1024 + h * 128 + half * 64 + c2); } while (0)
#define SCAN_STORE(bufi) do { LAS float* B_ = (LAS float*)(lds + (bufi) * 28672); \
        f32x4 q_, f_, k_; const float zq_[4] = {bflo(rq.x), bfhi(rq.x), bflo(rq.y), bfhi(rq.y)}, zf_[4] = {bflo(rf.x), bfhi(rf.x), bflo(rf.y), bfhi(rf.y)}; \
        _Pragma("unroll") for (int e_ = 0; e_ < 4; ++e_) { q_[e_] = silu_f(zq_[e_]) * 0.08838834764831845f; const float fv_ = lb4[e_] + (1.f - lb4[e_]) * sigmoid_f(zf_[e_]); f_[e_] = fv_; k_[e_] = 1.f - fv_; } \
        *(LAS f32x4*)(B_ + st * 128 + c4) = q_; *(LAS f32x4*)(B_ + 2048 + st * 128 + c4) = k_; *(LAS f32x4*)(B_ + 4096 + st * 128 + c4) = f_; \
        *(LAS f32x2*)(B_ + 6144 + st * 64 + c2) = (f32x2){bflo(rv), bfhi(rv)}; } while (0)
        SCAN_LOAD(0); SCAN_STORE(0);
        __syncthreads();
        for (int c = 0; c < nchunk; ++c) {
            const bool more = c + 1 < nchunk;
            if (more) SCAN_LOAD(c + 1);
            const LAS float* B = (const LAS float*)(lds + (c & 1) * 28672);
            LAS float* red = (LAS float*)(lds + 57344 + (c & 1) * 32768);
#pragma unroll
            for (int s2 = 0; s2 < 16; ++s2) {
                const float vv = B[6144 + s2 * 64 + lane];
                float acc = 0.f;
#pragma unroll
                for (int i4 = 0; i4 < 4; ++i4) {
                    const f32x4 q4 = *(const LAS f32x4*)(B + s2 * 128 + 16 * wave + 4 * i4), k4 = *(const LAS f32x4*)(B + 2048 + s2 * 128 + 16 * wave + 4 * i4), f4 = *(const LAS f32x4*)(B + 4096 + s2 * 128 + 16 * wave + 4 * i4);
#pragma unroll
                    for (int e = 0; e < 4; ++e) { const float sn_ = f4[e] * S[4 * i4 + e] + k4[e] * vv; S[4 * i4 + e] = sn_; acc += sn_ * q4[e]; }
                }
                red[(wave * 16 + s2) * 64 + lane] = acc;
            }
            if (more) SCAN_STORE((c + 1) & 1);
            __syncthreads();
            { float s0 = 0.f, s1 = 0.f;
#pragma unroll
              for (int w8 = 0; w8 < 8; ++w8) { const f32x2 t2 = *(const LAS f32x2*)(red + (w8 * 16 + st) * 64 + c2); s0 += t2.x; s1 += t2.y; }
              const int tp = dir ? (L - 1 - (c * 16 + st)) : (c * 16 + st);
              *(f32x2*)(og + (size_t)(row0 + tp) * D + h * 128 + half * 64 + c2) = (f32x2){s0, s1}; }
        }
#undef SCAN_LOAD
#undef SCAN_STORE
        if (!smp) { float* so = p.out + OUT_ST + ((size_t)((b * 2 + dir) * 8 + h) * 128 + 16 * wave) * 128 + half * 64 + lane;
#pragma unroll
            for (int jj = 0; jj < 16; ++jj) so[jj * 128] = S[jj]; }
        __syncthreads();
    }
}
__device__ __forceinline__ void hgate_phase(const Params& p) {
    const int tid = opaque_tid(), lane = tid & 63, wave = __builtin_amdgcn_readfirstlane(tid >> 6);
    const bf16* z = (const bf16*)(p.ws + WS_Z); bf16* o = (bf16*)(p.ws + WS_O);
    const float* of = (const float*)(p.ws + WS_OF); const float* ob = (const float*)(p.ws + WS_OB);
    for (int m = blockIdx.x * 8 + wave; m < M; m += gridDim.x * 8) {
        const f32x4* a = (const f32x4*)(of + (size_t)m * D + 16 * lane); const f32x4* bq = (const f32x4*)(ob + (size_t)m * D + 16 * lane);
        f32x4 v[4]; float ss = 0.f;
#pragma unroll
        for (int jj = 0; jj < 4; ++jj) { v[jj] = a[jj] + bq[jj]; ss += (v[jj].x * v[jj].x + v[jj].y * v[jj].y) + (v[jj].z * v[jj].z + v[jj].w * v[jj].w); }
        ss += __shfl_xor(ss, 1); ss += __shfl_xor(ss, 2); ss += __shfl_xor(ss, 4);
        const float rs = rsqrtf(ss * (1.f / 128.f) + EPS);
        const v4u g0 = *(const v4u*)(z + (size_t)m * 5120 + 4096 + 16 * lane), g1 = *(const v4u*)(z + (size_t)m * 5120 + 4096 + 16 * lane + 8);
        const f32x4* ng = (const f32x4*)(p.hgrn_norm_g + ((16 * lane) & 127));
        float r[16];
#pragma unroll
        for (int jj = 0; jj < 4; ++jj) { const f32x4 gg = ng[jj]; const unsigned ga = jj < 2 ? g0[2 * jj] : g1[2 * jj - 4], gb = jj < 2 ? g0[2 * jj + 1] : g1[2 * jj - 3];
            r[4 * jj] = v[jj].x * rs * gg.x * silu_f(bflo(ga)); r[4 * jj + 1] = v[jj].y * rs * gg.y * silu_f(bfhi(ga));
            r[4 * jj + 2] = v[jj].z * rs * gg.z * silu_f(bflo(gb)); r[4 * jj + 3] = v[jj].w * rs * gg.w * silu_f(bfhi(gb)); }
        v4u w0, w1; w0.x = pk2(r[0], r[1]); w0.y = pk2(r[2], r[3]); w0.z = pk2(r[4], r[5]); w0.w = pk2(r[6], r[7]);
        w1.x = pk2(r[8], r[9]); w1.y = pk2(r[10], r[11]); w1.z = pk2(r[12], r[13]); w1.w = pk2(r[14], r[15]);
        *(v4u*)(o + (size_t)m * D + 16 * lane) = w0; *(v4u*)(o + (size_t)m * D + 16 * lane + 8) = w1;
    }
}
constexpr int SC_QT = 0, SC_KT = 8704, SC_KH = 17408, SC_VT = 27648, SC_DD = 37888, SC_SEG = 38400, SC_QB = 42496;
__device__ __forceinline__ bf16x8 pack8(const f32x16& x, int s) {
    v4u w;
#pragma unroll
    for (int e = 0; e < 4; ++e) w[e] = pk2(x[8 * s + 2 * e], x[8 * s + 2 * e + 1]);
    return __builtin_bit_cast(bf16x8, w);
}
__device__ __forceinline__ bf16x8 ld2x64(const LAS bf16* p) { const v2u lo = *(const LAS v2u*)p, hi = *(const LAS v2u*)(p + 8); const v4u a = (v4u){lo.x, lo.y, hi.x, hi.y}; return __builtin_bit_cast(bf16x8, a); }

__device__ __forceinline__ void scan2_phase(const Params& p, LAS unsigned char* lds) {
    const int tid = opaque_tid(), lane = tid & 63, wave = __builtin_amdgcn_readfirstlane(tid >> 6);
    const bf16* z = (const bf16*)(p.ws + WS_Z);
    const float* lbt = (const float*)(p.ws + WS_LB);
    const int d0 = 2 * lane, seg = wave, half = lane >> 5, n = lane & 31;
    LAS bf16* QT = (LAS bf16*)(lds + SC_QT); LAS bf16* KT = (LAS bf16*)(lds + SC_KT); LAS bf16* KH = (LAS bf16*)(lds + SC_KH); LAS bf16* VT = (LAS bf16*)(lds + SC_VT);
    LAS bf16* QB = (LAS bf16*)(lds + SC_QB);
    LAS float* DD = (LAS float*)(lds + SC_DD); LAS float* SEG = (LAS float*)(lds + SC_SEG);
    for (int base = 0; base < 256; base += gridDim.x) {
        const int it = base + (int)blockIdx.x; if (it >= 256) break;
        const int njob = it < 128 ? 1 : 2;
#pragma unroll 1
        for (int job = 0; job < njob; ++job) {
            int row0, L, h, dir, bb; const bool smp = it < 128;
            if (smp) { bb = it >> 4; h = (it >> 1) & 7; dir = it & 1; row0 = MP + bb * 1024; L = 1024; }
            else { const int si = 2 * (it - 128) + job; bb = si >> 4; h = (si >> 1) & 7; dir = si & 1; row0 = bb * 256; L = 256; }
            const int nq = 4, qd0 = 0;
            const int nround = L >> 5;
            const bool cw = wave < nq; const int qd = qd0 + wave;
            const f32x2 lb = *(const f32x2*)(lbt + dir * 1024 + h * 128 + d0);
            f32x16 S[4];
#pragma unroll
            for (int blk = 0; blk < 4; ++blk)
#pragma unroll
                for (int i = 0; i < 16; ++i) S[blk][i] = 0.f;
            if (cw && smp) { const float* s0 = p.state_hgrn + (size_t)((bb * 2 + dir) * 8 + h) * 16384 + 32 * qd + n;
#pragma unroll
                for (int blk = 0; blk < 4; ++blk)
#pragma unroll
                    for (int i = 0; i < 16; ++i) S[blk][i] = s0[(32 * blk + crow(i, half)) * 128]; }
            unsigned rq[4], rf[4], rv[4];
#define SC2_LOAD(r_) do { _Pragma("unroll") for (int i_ = 0; i_ < 4; ++i_) { const int tau_ = 32 * (r_) + 4 * seg + i_; const int tok_ = dir ? (L - 1 - tau_) : tau_; \
            const bf16* zr_ = z + (size_t)(row0 + tok_) * 5120 + h * 128 + d0; rq[i_] = *(const unsigned*)zr_; rv[i_] = *(const unsigned*)(zr_ + 1024); rf[i_] = *(const unsigned*)(zr_ + 2048 + dir * 1024); } } while (0)
            SC2_LOAD(0);
            for (int r = 0; r < nround; ++r) {
                float lf[4][2], kk[4][2], qq[4][2];
                { float c0 = 0.f, c1 = 0.f;
#pragma unroll
                  for (int i = 0; i < 4; ++i) {
                      const float f0 = lb.x + (1.f - lb.x) * sigmoid_f(bflo(rf[i])), f1 = lb.y + (1.f - lb.y) * sigmoid_f(bfhi(rf[i]));
                      c0 += __logf(f0); c1 += __logf(f1); lf[i][0] = c0; lf[i][1] = c1; kk[i][0] = 1.f - f0; kk[i][1] = 1.f - f1;
                      qq[i][0] = silu_f(bflo(rq[i])) * 0.08838834764831845f; qq[i][1] = silu_f(bfhi(rq[i])) * 0.08838834764831845f; }
                  *(LAS f32x2*)(SEG + seg * 128 + d0) = (f32x2){c0, c1};
                  v2u w0, w1; w0.x = (rv[0] & 0xffffu) | (rv[1] << 16); w0.y = (rv[2] & 0xffffu) | (rv[3] << 16); w1.x = (rv[0] >> 16) | (rv[1] & 0xffff0000u); w1.y = (rv[2] >> 16) | (rv[3] & 0xffff0000u);
                  *(LAS v2u*)(VT + d0 * 40 + 4 * seg) = w0; *(LAS v2u*)(VT + (d0 + 1) * 40 + 4 * seg) = w1; }
                if (r + 1 < nround) SC2_LOAD(r + 1);
                __syncthreads();
                { float off0 = 0.f, off1 = 0.f, br0 = 0.f, br1 = 0.f, bl0 = 0.f, bl1 = 0.f;
#pragma unroll
                  for (int s = 0; s < 8; ++s) { const f32x2 t2 = *(const LAS f32x2*)(SEG + s * 128 + d0); if (s < seg) { off0 += t2.x; off1 += t2.y; } if (s < 4) { br0 += t2.x; br1 += t2.y; } bl0 += t2.x; bl1 += t2.y; }
                  const float eh0 = __expf(bl0 - br0), eh1 = __expf(bl1 - br1), er0 = __expf(br0), er1 = __expf(br1);
                  float kh0[4], kh1[4];
#pragma unroll
                  for (int i = 0; i < 4; ++i) { const int t = 4 * seg + i;
                      const float eq0 = __expf(off0 + lf[i][0] - br0), eq1 = __expf(off1 + lf[i][1] - br1), ek0 = __builtin_amdgcn_rcpf(eq0), ek1 = __builtin_amdgcn_rcpf(eq1);
                      const float kt0 = kk[i][0] * ek0, kt1 = kk[i][1] * ek1;
                      *(LAS unsigned*)(QT + t * 136 + d0) = pk2(qq[i][0] * eq0, qq[i][1] * eq1); *(LAS unsigned*)(QB + t * 136 + d0) = pk2(qq[i][0] * eq0 * er0, qq[i][1] * eq1 * er1); *(LAS unsigned*)(KT + t * 136 + d0) = pk2(kt0, kt1);
                      kh0[i] = kt0 * eh0; kh1[i] = kt1 * eh1; }
                  v2u w0, w1; w0.x = pk2(kh0[0], kh0[1]); w0.y = pk2(kh0[2], kh0[3]); w1.x = pk2(kh1[0], kh1[1]); w1.y = pk2(kh1[2], kh1[3]);
                  *(LAS v2u*)(KH + d0 * 40 + 4 * seg) = w0; *(LAS v2u*)(KH + (d0 + 1) * 40 + 4 * seg) = w1;
                  if (seg == 7) *(LAS f32x2*)(DD + d0) = (f32x2){__expf(bl0), __expf(bl1)}; }
                __syncthreads();
                if (cw) {
                    f32x16 X;
#pragma unroll
                    for (int i = 0; i < 16; ++i) X[i] = 0.f;
#pragma unroll
                    for (int ks = 0; ks < 8; ++ks) { const bf16x8 a = *(const LAS bf16x8*)(KT + n * 136 + 16 * ks + 8 * half), bq = *(const LAS bf16x8*)(QT + n * 136 + 16 * ks + 8 * half);
                        X = __builtin_amdgcn_mfma_f32_32x32x16_bf16(a, bq, X, 0, 0, 0); }
#pragma unroll
                    for (int i = 0; i < 16; ++i) if (crow(i, half) > n) X[i] = 0.f;
                    f32x16 O;
#pragma unroll
                    for (int i = 0; i < 16; ++i) O[i] = 0.f;
#pragma unroll
                    for (int s2 = 0; s2 < 2; ++s2) O = __builtin_amdgcn_mfma_f32_32x32x16_bf16(ld2x64(VT + (32 * qd + n) * 40 + 16 * s2 + 4 * half), pack8(X, s2), O, 0, 0, 0);
#pragma unroll
                    for (int blk = 0; blk < 4; ++blk)
#pragma unroll
                        for (int s2 = 0; s2 < 2; ++s2) O = __builtin_amdgcn_mfma_f32_32x32x16_bf16(pack8(S[blk], s2), ld2x64(QB + n * 136 + 32 * blk + 16 * s2 + 4 * half), O, 0, 0, 0);
                    { const int tau = 32 * r + n, tok = dir ? (L - 1 - tau) : tau;
                      float* og = (float*)(p.ws + (dir ? WS_OB : WS_OF)) + (size_t)(row0 + tok) * D + h * 128 + 32 * qd + 4 * half;
#pragma unroll
                      for (int g = 0; g < 4; ++g) *(f32x4*)(og + 8 * g) = (f32x4){O[4 * g], O[4 * g + 1], O[4 * g + 2], O[4 * g + 3]}; }
#pragma unroll
                    for (int blk = 0; blk < 4; ++blk) {
#pragma unroll
                        for (int g = 0; g < 4; ++g) { const f32x4 dv4 = *(const LAS f32x4*)(DD + 32 * blk + 8 * g + 4 * half);
#pragma unroll
                            for (int e = 0; e < 4; ++e) S[blk][4 * g + e] *= dv4[e]; }
#pragma unroll
                        for (int k2 = 0; k2 < 2; ++k2) { const bf16x8 a = *(const LAS bf16x8*)(KH + (32 * blk + n) * 40 + 16 * k2 + 8 * half), bv = *(const LAS bf16x8*)(VT + (32 * qd + n) * 40 + 16 * k2 + 8 * half);
                            S[blk] = __builtin_amdgcn_mfma_f32_32x32x16_bf16(a, bv, S[blk], 0, 0, 0); }
                    }
                }
                __syncthreads();
            }
#undef SC2_LOAD
            if (cw && !smp) { float* so = p.out + OUT_ST + (size_t)((bb * 2 + dir) * 8 + h) * 16384 + 32 * qd + n;
#pragma unroll
                for (int blk = 0; blk < 4; ++blk)
#pragma unroll
                    for (int i = 0; i < 16; ++i) so[(32 * blk + crow(i, half)) * 128] = S[blk][i]; }
        }
    }
}
#ifndef PROBE
#define PROBE 0
#endif
#if PROBE == 1
#define GSYNC() do { xcd_barrier(bar); xcd_barrier(bar); } while (0)
#else
#define GSYNC() xcd_barrier(bar)
#endif
__global__ void __launch_bounds__(NTHR, 2) fwd_megakernel(Params p) {
    extern __shared__ __attribute__((aligned(16))) unsigned char lds_raw[];
    cg::grid_group grid = cg::this_grid();
    LAS unsigned char* lds = (LAS unsigned char*)lds_raw;
    const int G = gridDim.x;
    { const int t0 = opaque_tid(); if (t0 < 64) ((LAS unsigned*)(lds + MISC_OFF))[t0] = 0u; }
    __syncthreads();
    const XcdBarrier bar = xcd_barrier_post((unsigned*)(p.ws + WS_CTL), (volatile LAS unsigned*)(lds + MISC_OFF) + 8);
    const float* mod = (const float*)(p.ws + WS_MOD);
    bf16* hn = (bf16*)(p.ws + WS_HN); bf16* zb = (bf16*)(p.ws + WS_Z); float* hb = (float*)(p.ws + WS_H); bf16* ob = (bf16*)(p.ws + WS_O);

    p0_prologue(p, lds);
#if PROBE == 2
    __syncthreads(); p0_prologue(p, lds);
#endif
    grid.sync();

#pragma unroll 1
    for (int li = 0; li < DEPTH; ++li) {
        const int kind = li % 3, jm = li / 3;
        const float* modl = mod + (size_t)li * 9 * 9216;
        const float* ng = p.norm_g + (size_t)li * 6 * 1024;
#pragma unroll 1
        for (int sub = 0; sub < 3; ++sub) {
            {
                const bool first = (li == 0 && sub == 0);
                const float* modh; const float* gpost; int gate_idx; float rscale;
                if (sub == 0) { modh = modl - 9 * 9216; gpost = ng - 6 * 1024 + 5 * 1024; gate_idx = 8; rscale = 0.5f; if (first) { modh = modl; gpost = ng; } }
                else if (sub == 1) { modh = modl; gpost = ng + 1 * 1024; gate_idx = 2; rscale = 0.5f; }
                else { modh = modl; gpost = ng + 3 * 1024; gate_idx = 5; rscale = 1.0f; }
                ew_phase(p, first, true, rscale, modh, gate_idx, gpost, modl, sub, ng + 2 * sub * 1024);
            }
            GSYNC();
            const bf16* A2; const bf16* B2; int K2;
            if (sub != 1) {
                const int wi = li * 2 + (sub >> 1);
                pg8::Gemm g{hn, (const bf16*)(p.ws + WS_FFNIN) + (size_t)wi * 5632 * 1024, M, 5632, 1024}; pg8::StaticOrder S; S.init(M, 5632, G, (int)blockIdx.x);
                EpiSwiGLU E{zb};
                pg8::gemm_phase<EpiSwiGLU, pg8::StaticOrder, true, true>(lds, g, S, E);
#if PROBE == 5
                pg8::gemm_phase<EpiSwiGLU, pg8::StaticOrder, true, true>(lds, g, S, E);
#endif
                GSYNC();
                A2 = zb; B2 = (const bf16*)(p.ws + WS_FFNOUT) + (size_t)wi * 1024 * 2816; K2 = 2816;
            } else {
                const bf16* Bi; int Ni; float* kout = nullptr; float* vout = nullptr;
                if (kind == 0) { Bi = (const bf16*)(p.ws + WS_QKV) + (size_t)jm * 1536 * 1024; Ni = 1536; kout = p.out + OUT_K + (size_t)jm * 65536; vout = p.out + OUT_V + (size_t)jm * 65536; B2 = (const bf16*)(p.ws + WS_AO) + (size_t)jm * 1024 * 1024; }
                else if (kind == 1) { Bi = (const bf16*)(p.ws + WS_CIN); Ni = 3072; B2 = (const bf16*)(p.ws + WS_COUT); }
                else { Bi = (const bf16*)(p.ws + WS_HIN); Ni = 5120; B2 = (const bf16*)(p.ws + WS_HOUT); }
                {
                    pg8::Gemm g{hn, Bi, M, Ni, 1024}; pg8::StaticOrder S; S.init(M, Ni, G, (int)blockIdx.x);
                    EpiZ E{zb, Ni, kout, vout};
                    pg8::gemm_phase<EpiZ, pg8::StaticOrder, true, true>(lds, g, S, E);
                }
                GSYNC();
                if (kind == 0) { attn_phase(p, lds, jm);
#if PROBE == 4
                    attn_phase(p, lds, jm);
#endif
                }
                else if (kind == 1) conv_phase(p);
                else { scan2_phase(p, lds);
#if PROBE == 3
                    scan2_phase(p, lds);
#endif
                    GSYNC(); hgate_phase(p); }
                GSYNC();
                A2 = ob; K2 = 1024;
            }
            {
                pg8::Gemm g{A2, B2, M, 1024, K2}; pg8::StaticOrder S; S.init(M, 1024, G, (int)blockIdx.x);
                EpiF32 E{hb};
                pg8::gemm_phase<EpiF32, pg8::StaticOrder, true, true>(lds, g, S, E);
#if PROBE == 6
                pg8::gemm_phase<EpiF32, pg8::StaticOrder, true, true>(lds, g, S, E);
#endif
            }
            GSYNC();
        }
    }
    ew_phase(p, false, false, 0.5f, mod + (size_t)3 * 9 * 9216, 8, p.norm_g + (size_t)(3 * 6 + 5) * 1024, mod, 0, p.norm_g);
}

extern "C" void kernel_launch(void* const* d_in, const int* in_sizes, int n_in, void* d_out, int out_size, void* d_ws, size_t ws_size, hipStream_t stream) {
    static int grid = 0;
    if (grid == 0) {
        if (n_in != 23 || ws_size < WS_END) { fprintf(stderr, "kernel_launch: expected 23 inputs and >= %zu bytes of workspace; got %d, %zu\n", (size_t)WS_END, n_in, ws_size); grid = -1; return; }
        int dev = 0, cus = 0, per_cu = 0;
        hipGetDevice(&dev); hipDeviceGetAttribute(&cus, hipDeviceAttributeMultiprocessorCount, dev);
        if (hipFuncSetAttribute((const void*)fwd_megakernel, hipFuncAttributeMaxDynamicSharedMemorySize, LDS_BYTES) != hipSuccess) { fprintf(stderr, "kernel_launch: hipFuncSetAttribute failed\n"); grid = -1; return; }
        if (hipOccupancyMaxActiveBlocksPerMultiprocessor(&per_cu, (const void*)fwd_megakernel, NTHR, LDS_BYTES) != hipSuccess || per_cu < 1) { fprintf(stderr, "kernel_launch: occupancy query gave %d\n", per_cu); per_cu = 1; }
        (void)hipGetLastError();
        grid = cus * per_cu;
    }
    if (grid < 0) return;
    if (hipMemsetAsync((char*)d_ws + WS_CTL, 0, CTL_BYTES, stream) != hipSuccess) { fprintf(stderr, "kernel_launch: hipMemsetAsync failed\n"); return; }
    Params p{};
    const float** pp = (const float**)&p;
    for (int i = 0; i < 23; ++i) pp[i] = (const float*)d_in[i];
    p.out = (float*)d_out; p.ws = (unsigned char*)d_ws;
    void* args[] = {&p};
    hipError_t e = hipLaunchCooperativeKernel((const void*)fwd_megakernel, dim3(grid), dim3(NTHR), args, LDS_BYTES, stream);
    if (e != hipSuccess) fprintf(stderr, "cooperative launch failed: %s (grid %d)\n", hipGetErrorString(e), grid);
}
```
